# Optimizing an MI355X kernel written in HIP

```python
import jax
import jax.numpy as jnp
from jax import lax
import numpy as np

D_MODEL = 2048
BATCH = 8
SEQ = 2048
DEPTH = 1

HEAD_DIM = 128
MIX_WIDTH = D_MODEL
ATTN_WIDTH = MIX_WIDTH // 2
GMLP_WIDTH = MIX_WIDTH - ATTN_WIDTH
ATTN_HEADS = ATTN_WIDTH // HEAD_DIM
KV_HEADS = max(1, ATTN_HEADS // 4)
Q_PER_KV = ATTN_HEADS // KV_HEADS
KV_WIDTH = KV_HEADS * HEAD_DIM
GMLP_HEAD_DIM = 128
GMLP_HEADS = GMLP_WIDTH // GMLP_HEAD_DIM
IN_WIDTH = ATTN_WIDTH + 2 * KV_WIDTH + 2 * GMLP_WIDTH
WINDOW = 128
BLOCK = 128
CHUNK = 128
ROPE_THETA = 500000.0
ROPE_DIM = HEAD_DIM // 4
N_GROUPS = 4
EXPERTS_PER_GROUP = 4
TOP_K = 2
D_EXPERT = D_MODEL // 2
N_MOD = 6
EPS = 1e-6
NEG_INF = -1e30

kernel_name = 'hybrid_swa_gmlp_hmoe_block'


def rms_norm(x, g):
    xf = x.astype(jnp.float32)
    y = xf * lax.rsqrt(jnp.mean(xf * xf, axis=-1, keepdims=True) + EPS)
    return (y * g.astype(jnp.float32)).astype(x.dtype)


def partial_rope(x, positions):
    half = ROPE_DIM // 2
    inv_freq = ROPE_THETA ** (-jnp.arange(half, dtype=jnp.float32) * 2.0 / ROPE_DIM)
    ang = positions.astype(jnp.float32)[..., None] * inv_freq
    cos = jnp.cos(ang)[:, :, None, :]
    sin = jnp.sin(ang)[:, :, None, :]
    xf = x.astype(jnp.float32)
    x1 = xf[..., :half]
    x2 = xf[..., half:ROPE_DIM]
    out = jnp.concatenate([x1 * cos - x2 * sin, x2 * cos + x1 * sin, xf[..., ROPE_DIM:]], axis=-1)
    return out.astype(x.dtype)


def window_attention(q, k, v, sink):
    B, S = q.shape[0], q.shape[1]
    nb = S // BLOCK
    qb = q.reshape(B, nb, BLOCK, KV_HEADS, Q_PER_KV, HEAD_DIM)

    def band(t):
        tp = jnp.pad(t, ((0, 0), (BLOCK, BLOCK), (0, 0), (0, 0)))
        tb = tp.reshape(B, nb + 2, BLOCK, KV_HEADS, HEAD_DIM)
        return jnp.concatenate([tb[:, :-2], tb[:, 1:-1], tb[:, 2:]], axis=2)

    kb = band(k)
    vb = band(v)
    s = jnp.einsum('bnqhgd,bnkhd->bnhgqk', qb, kb).astype(jnp.float32) * (HEAD_DIM ** -0.5)
    q_off = jnp.arange(BLOCK)[:, None]
    k_off = jnp.arange(3 * BLOCK)[None, :] - BLOCK
    k_glob = jnp.arange(nb)[:, None, None] * BLOCK + k_off[None]
    valid = (jnp.abs(k_off - q_off) <= WINDOW)[None] & (k_glob >= 0) & (k_glob < S)
    s = jnp.where(valid[None, :, None, None], s, NEG_INF)
    sink_col = jnp.broadcast_to(sink.astype(jnp.float32).reshape(1, 1, KV_HEADS, Q_PER_KV, 1, 1),
                                s.shape[:-1] + (1,))
    p = jax.nn.softmax(jnp.concatenate([s, sink_col], axis=-1), axis=-1)[..., :-1]
    o = jnp.einsum('bnhgqk,bnkhd->bnqhgd', p.astype(v.dtype), vb)
    return o.reshape(B, S, ATTN_WIDTH)


def spatial_gating(u, v, g_norm, w_s, b_s):
    B, S = u.shape[0], u.shape[1]
    nc = S // CHUNK
    u = jax.nn.gelu(u, approximate=False).reshape(B, S, GMLP_HEADS, GMLP_HEAD_DIM)
    vf = jax.nn.gelu(v.astype(jnp.float32), approximate=False).reshape(B, S, GMLP_HEADS, GMLP_HEAD_DIM)
    mu = jnp.mean(vf, axis=-1, keepdims=True)
    var = jnp.mean(jnp.square(vf - mu), axis=-1, keepdims=True)
    vf = (vf - mu) * lax.rsqrt(var + EPS) * g_norm.astype(jnp.float32)
    vc = vf.astype(u.dtype).reshape(B, nc, CHUNK, GMLP_HEADS, GMLP_HEAD_DIM)
    mixed = jnp.einsum('hpq,bcqhd->bcphd', w_s, vc) + b_s.T[None, None, :, :, None]
    return (u * mixed.reshape(B, S, GMLP_HEADS, GMLP_HEAD_DIM)).reshape(B, S, GMLP_WIDTH)


def token_mixer(a, positions, w_in, sink, g_norm, w_s, b_s, g_group, w_out):
    B, S = a.shape[0], a.shape[1]
    z = a @ w_in
    o0 = ATTN_WIDTH
    o1 = o0 + KV_WIDTH
    o2 = o1 + KV_WIDTH
    o3 = o2 + GMLP_WIDTH
    q = partial_rope(z[..., :o0].reshape(B, S, ATTN_HEADS, HEAD_DIM), positions)
    k = partial_rope(z[..., o0:o1].reshape(B, S, KV_HEADS, HEAD_DIM), positions)
    v = z[..., o1:o2].reshape(B, S, KV_HEADS, HEAD_DIM)
    y_attn = window_attention(q, k, v, sink)
    y_gmlp = spatial_gating(z[..., o2:o3], z[..., o3:], g_norm, w_s, b_s)
    y = jnp.concatenate([rms_norm(y_attn, g_group[:ATTN_WIDTH]),
                         rms_norm(y_gmlp, g_group[ATTN_WIDTH:])], axis=-1)
    return y @ w_out


def hier_moe(f, w_rg, b_rg, w_re, b_re, w_gate, w_up, w_down):
    B, S, D = f.shape
    t = f.reshape(B * S, D)
    g_logits = (t @ w_rg).astype(jnp.float32) + b_rg.astype(jnp.float32)
    g_val, g_idx = lax.top_k(jax.nn.softmax(g_logits, axis=-1), 1)
    e_logits = jnp.einsum('td,dge->tge', t, w_re).astype(jnp.float32) + b_re.astype(jnp.float32)
    e_sel = jnp.take_along_axis(e_logits, g_idx[:, :, None], axis=1)[:, 0]
    e_val, e_idx = lax.top_k(jax.nn.softmax(e_sel, axis=-1), TOP_K)
    e_w = e_val / jnp.sum(e_val, axis=-1, keepdims=True) * g_val
    comb = jnp.sum(jax.nn.one_hot(e_idx, EXPERTS_PER_GROUP, dtype=jnp.float32) * e_w[..., None], axis=1)
    comb = jax.nn.one_hot(g_idx[:, 0], N_GROUPS, dtype=jnp.float32)[:, :, None] * comb[:, None, :]
    comb = comb.astype(t.dtype)
    y = jnp.zeros_like(t)
    for g in range(N_GROUPS):
        h_gate = jnp.einsum('td,edf->etf', t, w_gate[g])
        h_up = jnp.einsum('td,edf->etf', t, w_up[g])
        hid = jax.nn.silu(h_gate) * h_up * comb[:, g].T[:, :, None]
        y = y + jnp.einsum('etf,efd->td', hid, w_down[g])
    return y.reshape(B, S, D)


def setup_inputs(seed: int = 0) -> dict:
    key = jax.random.key(seed)
    ks = jax.random.split(key, 24)
    f32 = jnp.float32

    def nrm(k, shape, scale):
        return jax.random.normal(k, shape, f32) * scale

    def gain(k, shape):
        return 1.0 + 0.02 * jax.random.normal(k, shape, f32)

    G, E, D, F = N_GROUPS, EXPERTS_PER_GROUP, D_MODEL, D_EXPERT
    x = nrm(ks[0], (BATCH, SEQ, D), 1.0)
    c = nrm(ks[1], (BATCH, D), 1.0)
    offset = jax.random.randint(ks[2], (BATCH, 1), 0, 4096, dtype=jnp.int32)
    positions = offset + jnp.arange(SEQ, dtype=jnp.int32)[None, :]
    return {
        'x': x,
        'c': c,
        'positions': positions,
        'w_ada': nrm(ks[3], (DEPTH, D, N_MOD * D), 0.5 * D ** -0.5),
        'b_ada': nrm(ks[4], (DEPTH, N_MOD * D), 0.02),
        'g_mix_pre': gain(ks[5], (DEPTH, D)),
        'g_mix_post': gain(ks[6], (DEPTH, D)),
        'w_in': nrm(ks[7], (DEPTH, D, IN_WIDTH), D ** -0.5),
        'sink_logits': nrm(ks[8], (DEPTH, ATTN_HEADS), 1.0),
        'gmlp_norm_g': gain(ks[9], (DEPTH, GMLP_HEADS, GMLP_HEAD_DIM)),
        'w_spatial': nrm(ks[10], (DEPTH, GMLP_HEADS, CHUNK, CHUNK), CHUNK ** -0.5),
        'b_spatial': gain(ks[11], (DEPTH, GMLP_HEADS, CHUNK)),
        'g_group_out': gain(ks[12], (DEPTH, MIX_WIDTH)),
        'w_out': nrm(ks[13], (DEPTH, MIX_WIDTH, D), MIX_WIDTH ** -0.5),
        'g_ffn_pre': gain(ks[14], (DEPTH, D)),
        'g_ffn_post': gain(ks[15], (DEPTH, D)),
        'w_router_group': nrm(ks[16], (DEPTH, D, G), D ** -0.5),
        'b_router_group': nrm(ks[17], (DEPTH, G), 0.01),
        'w_router_expert': nrm(ks[18], (DEPTH, D, G, E), D ** -0.5),
        'b_router_expert': nrm(ks[19], (DEPTH, G, E), 0.01),
        'w_gate': nrm(ks[20], (DEPTH, G, E, D, F), D ** -0.5),
        'w_up': nrm(ks[21], (DEPTH, G, E, D, F), D ** -0.5),
        'w_down': nrm(ks[22], (DEPTH, G, E, F, D), F ** -0.5),
    }


def reference(x, c, positions, w_ada, b_ada, g_mix_pre, g_mix_post, w_in, sink_logits,
              gmlp_norm_g, w_spatial, b_spatial, g_group_out, w_out, g_ffn_pre, g_ffn_post,
              w_router_group, b_router_group, w_router_expert, b_router_expert,
              w_gate, w_up, w_down):
    h = x
    c_act = jax.nn.silu(c)
    for l in range(DEPTH):
        mod = c_act @ w_ada[l] + b_ada[l]
        sh1, sc1, gt1, sh2, sc2, gt2 = jnp.split(mod[:, None, :], N_MOD, axis=-1)
        a = rms_norm(h, g_mix_pre[l]) * (1 + sc1) + sh1
        mix = token_mixer(a, positions, w_in[l], sink_logits[l], gmlp_norm_g[l],
                          w_spatial[l], b_spatial[l], g_group_out[l], w_out[l])
        h = h + gt1 * rms_norm(mix, g_mix_post[l])
        f = rms_norm(h, g_ffn_pre[l]) * (1 + sc2) + sh2
        y = hier_moe(f, w_router_group[l], b_router_group[l], w_router_expert[l],
                     b_router_expert[l], w_gate[l], w_up[l], w_down[l])
        h = h + gt2 * rms_norm(y, g_ffn_post[l])
    return h
```

```cpp
#include <hip/hip_runtime.h>
#include <cstdio>
#include <cstdint>
#include <cstring>

#ifndef MOE_FP8
#define MOE_FP8 1
#endif

constexpr int D = 2048, NB = 8, S = 2048, T = NB * S, HD = 128, AW = 1024, AH = 8, KVH = 2, GH = 8, INW = 3584;
constexpr int WIN = 128, CH = 128, NG = 4, EPG = 4, NE = 16, FF = 1024, NMOD = 6, MODW = NMOD * D;
constexpr int OQ = 0, OK_ = 1024, OV = 1280, OU = 1536, OVG = 2560;
constexpr float EPS = 1e-6f;
constexpr float LOG2E = 1.4426950408889634f;
constexpr float C2 = 0.08838834764831845f * LOG2E;
constexpr int HID_ROWS = 2 * T + NE * 256;
constexpr int SSPW = 32;

typedef unsigned short bf16;
typedef short bf16x8 __attribute__((ext_vector_type(8)));
typedef short s16x4 __attribute__((ext_vector_type(4)));
typedef short v4i16_t __attribute__((ext_vector_type(4)));
typedef float f32x2 __attribute__((ext_vector_type(2)));
typedef float f32x4 __attribute__((ext_vector_type(4)));
typedef float f32x16 __attribute__((ext_vector_type(16)));
typedef unsigned u32x2 __attribute__((ext_vector_type(2)));
typedef unsigned u32x4 __attribute__((ext_vector_type(4)));
#define DI __device__ __forceinline__
#define GAS __attribute__((address_space(1)))
#define LAS __attribute__((address_space(3)))
typedef GAS unsigned gu32;

constexpr size_t MiB = 1u << 20;
constexpr size_t WS_CTL = 0, CTL_ZERO_BYTES = 65536;
constexpr size_t WS_MOD = 1 * MiB;
constexpr size_t WS_ROPE = 3 * MiB;
constexpr size_t WS_SSP = 5 * MiB;
constexpr size_t WS_LIST = 7 * MiB;
constexpr size_t WS_LW = 8 * MiB;
constexpr size_t WS_WRG = 9 * MiB;
constexpr size_t WS_WRE = 9 * MiB + 65536;
constexpr size_t WS_WSB = 9 * MiB + 262144;
constexpr size_t WS_ASC = 9 * MiB + 786432;
constexpr size_t WS_WIN = 10 * MiB;
constexpr size_t WS_WO = 24 * MiB;
constexpr size_t WS_WGU = 32 * MiB;
constexpr size_t WS_WD = 160 * MiB;
constexpr size_t WS_A = 224 * MiB;
constexpr size_t WS_Z = 288 * MiB;
constexpr size_t WS_Y = 400 * MiB;
constexpr size_t WS_HB = 400 * MiB;
constexpr size_t WS_MIX = 464 * MiB;
constexpr size_t WS_HID = 288 * MiB;
constexpr size_t WS_YK = 464 * MiB;
constexpr size_t WS_END = 592 * MiB;
constexpr int CW_TMO = 0, CW_CNT = 64, CW_WMAX = 96, CW_BAR = 4096;

DI float bf2f(bf16 h) { return __uint_as_float(((unsigned)h) << 16); }
DI bf16 f2bf(float f) { unsigned u = __float_as_uint(f); return (bf16)((u + 0x7fffu + ((u >> 16) & 1u)) >> 16); }
DI unsigned cvt_pk_bf16(float lo, float hi) { unsigned r; asm volatile("v_cvt_pk_bf16_f32 %0, %1, %2" : "=v"(r) : "v"(lo), "v"(hi)); return r; }
typedef float f32x2_t __attribute__((ext_vector_type(2))); typedef __bf16 bf16x2_t __attribute__((ext_vector_type(2)));
DI unsigned cvtpk_s(float lo, float hi) { f32x2_t v = {lo, hi}; bf16x2_t b = __builtin_convertvector(v, bf16x2_t); return __builtin_bit_cast(unsigned, b); }
DI unsigned pack4_i8(float a, float b, float c, float d) { const int q0 = (int)rintf(a), q1 = (int)rintf(b), q2 = (int)rintf(c), q3 = (int)rintf(d); return (unsigned)(q0 & 255) | ((unsigned)(q1 & 255) << 8) | ((unsigned)(q2 & 255) << 16) | ((unsigned)q3 << 24); }
DI float clamp127(float v) { return __builtin_amdgcn_fmed3f(v, -127.f, 127.f); }
DI u32x4 pair16(u32x2 a, u32x2 b) { const auto r0 = __builtin_amdgcn_permlane16_swap(a.x, b.x, false, false); const auto r1 = __builtin_amdgcn_permlane16_swap(a.y, b.y, false, false); return (u32x4){r0[0], r1[0], r0[1], r1[1]}; }
constexpr float W8_SCALE = 32.f, H8_SCALE = 16.f, Y8_SCALE = 64.f, YA_SCALE = 4.f;
DI float clamp8(float v) { return __builtin_amdgcn_fmed3f(v, -448.f, 448.f); }
DI unsigned pack4_fp8(float a, float b, float c, float d) { int p = 0; p = __builtin_amdgcn_cvt_pk_fp8_f32(clamp8(a), clamp8(b), p, false); p = __builtin_amdgcn_cvt_pk_fp8_f32(clamp8(c), clamp8(d), p, true); return (unsigned)p; }
typedef int v4i32 __attribute__((ext_vector_type(4))); typedef int v8i32 __attribute__((ext_vector_type(8)));
DI v8i32 cat8(bf16x8 lo, bf16x8 hi) { const v4i32 a = __builtin_bit_cast(v4i32, lo), b = __builtin_bit_cast(v4i32, hi); return __builtin_shufflevector(a, b, 0, 1, 2, 3, 4, 5, 6, 7); }
#define DPP_ADD(v, ctrl) (v) += __builtin_bit_cast(float, __builtin_amdgcn_update_dpp(0, __builtin_bit_cast(int, (v)), (ctrl), 0xF, 0xF, true))
DI float wave_sum(float v) {
    DPP_ADD(v, 0x111); DPP_ADD(v, 0x112); DPP_ADD(v, 0x114); DPP_ADD(v, 0x118);
    const int b = __builtin_bit_cast(int, v);
    return (__builtin_bit_cast(float, __builtin_amdgcn_readlane(b, 15)) + __builtin_bit_cast(float, __builtin_amdgcn_readlane(b, 31))) + (__builtin_bit_cast(float, __builtin_amdgcn_readlane(b, 47)) + __builtin_bit_cast(float, __builtin_amdgcn_readlane(b, 63)));
}
DI float sum16(float v) {
    DPP_ADD(v, 0xB1); DPP_ADD(v, 0x4E); DPP_ADD(v, 0x141); DPP_ADD(v, 0x140); return v;
}
DI float xsum32(float v) { const auto rr = __builtin_amdgcn_permlane32_swap(__float_as_uint(v), __float_as_uint(v), false, false); return __uint_as_float(rr[0]) + __uint_as_float(rr[1]); }
DI float xmax32(float v) { const auto rr = __builtin_amdgcn_permlane32_swap(__float_as_uint(v), __float_as_uint(v), false, false); return fmaxf(__uint_as_float(rr[0]), __uint_as_float(rr[1])); }
DI float xother32(float v) { const unsigned b = __float_as_uint(v); const auto rr = __builtin_amdgcn_permlane32_swap(b, b, false, false); return __uint_as_float(rr[0] ^ rr[1] ^ b); }
DI f32x2 gelu_pk(f32x2 v) {
    const f32x2 av = __builtin_elementwise_abs(v), d = av * 0.2316418882f + 1.0f;
    f32x2 t; t.x = __builtin_amdgcn_rcpf(d.x); t.y = __builtin_amdgcn_rcpf(d.y);
    f32x2 q = t * 0.5307027145f + (-0.7265760135f); q = q * t + 0.7107068705f; q = q * t + (-0.142248368f); q = q * t + 0.127414796f; q = q * t;
    const f32x2 s = (v * v) * (-0.72134752044f);
    f32x2 e; e.x = __builtin_amdgcn_exp2f(s.x); e.y = __builtin_amdgcn_exp2f(s.y);
    const f32x2 m = v * (q * e), r = v - m;
    f32x2 o; o.x = v.x < 0.f ? m.x : r.x; o.y = v.y < 0.f ? m.y : r.y; return o;
}
#define LDS_WAIT() asm volatile("s_waitcnt lgkmcnt(0)" ::: "memory")
#define VM_WAIT() asm volatile("s_waitcnt vmcnt(0)" ::: "memory")
#define RLX_AGENT __ATOMIC_RELAXED, __HIP_MEMORY_SCOPE_AGENT

namespace pg8 {
constexpr int BM = 256, BK = 64, HALF = 128, HTB = HALF * BK * 2, NXCD = 8, WGM = 8;
__host__ __device__ __forceinline__ int lds_byte(int r, int c) { const int st = (r >> 4) * 2 + (c >> 5), rr = r & 15, cc = c & 31, ob = rr * 64 + cc * 2; return st * 1024 + (ob ^ (((ob >> 9) & 1) << 5)); }
__host__ __device__ __forceinline__ void stage_rc(int b, int& R, int& C) { const int st = b / 1024, sb = b % 1024, swz = sb ^ (((sb >> 9) & 1) << 5); R = (st >> 1) * 16 + swz / 64; C = (st & 1) * 32 + (swz % 64) / 2; }
__host__ __device__ __forceinline__ int perm32(int rho) { const int n = rho >> 4, i = rho & 15; return 8 * (i >> 2) + 4 * n + (i & 3); }

struct Unit { int pm, pn, e, slot; };

struct DenseOrder {
    const char* A; const char* Bt; int K; int nM, nN, nwg, G, c;
    DI void init(const void* A_, const void* Bt_, int M, int N, int K_, int G_, int c_) { A = (const char*)A_; Bt = (const char*)Bt_; K = K_; nM = M / BM; nN = N / BM; nwg = nM * nN; G = G_; c = c_; }
    DI bool next(int i, Unit& u) const {
        const long L = (long)i * G + c; if (L >= nwg) return false;
        int wgid = (int)L; { const int q = nwg / NXCD, r = nwg % NXCD, xcd = wgid % NXCD, off = wgid / NXCD; wgid = (xcd < r ? xcd * (q + 1) : r * (q + 1) + (xcd - r) * q) + off; }
        const int nig = WGM * nN, gid = wgid / nig, fm = gid * WGM, gsz = (nM - fm) < WGM ? (nM - fm) : WGM;
        u.pm = fm + ((wgid % nig) % gsz); u.pn = (wgid % nig) / gsz; u.e = 0; u.slot = i; return true;
    }
    bool gather = false;
    DI const char* a_base(const Unit& u) const { return gather ? A : A + (size_t)u.pm * BM * K * 2; }
    DI const char* b_base(const Unit& u) const { return Bt + (size_t)u.pn * BM * K * 2; }
};
#ifndef INP_I8
#define INP_I8 1
#endif
#ifndef OUT_F8
#define OUT_F8 1
#endif
#ifndef YK_FP8
#define YK_FP8 1
#endif
#ifndef MOE_XCD
#define MOE_XCD 0
#endif
struct MoeOrder {
    const char* A; const char* Bt; int K, nN; size_t bstride  ; LAS const int* tp; int G, c; bool gather;
    DI bool xcd() const { return MOE_XCD && (G % 8 == 0); }
    DI int group_units(int x) const { return ((tp[x + 1] - tp[x]) + (tp[x + 9] - tp[x + 8])) * nN; }
    DI int my_units() const {
        if (xcd()) { const int W = G >> 3, r = c >> 3, U = group_units(c & 7); return U > r ? (U - r + W - 1) / W : 0; }
        const int tot = tp[NE] * nN; return tot > c ? (tot - c + G - 1) / G : 0;
    }
    DI int max_units() const {
        if (xcd()) { const int W = G >> 3; int m = 0;
#pragma unroll
            for (int x = 0; x < 8; ++x) { const int q = (group_units(x) + W - 1) / W; m = q > m ? q : m; } return m; }
        return (tp[NE] * nN + G - 1) / G;
    }
    DI bool next(int i, Unit& u) const {
        if (xcd()) {
            const int x = c & 7, r = c >> 3, W = G >> 3; const int t0 = tp[x + 1] - tp[x], t1 = tp[x + 9] - tp[x + 8];
            int k = r + W * i; if (k >= (t0 + t1) * nN) return false;
            int e = x; if (k >= t0 * nN) { e = x + 8; k -= t0 * nN; }
            u.e = e; u.pm = k / nN; u.pn = k % nN; u.slot = i; return true;
        }
        const int L = i * G + c; const int tot = tp[NE] * nN; if (L >= tot) return false;
        const int mt = L / nN; u.pn = L % nN; int e = 0;
#pragma unroll
        for (int k = 1; k < NE; ++k) e += (mt >= tp[k]) ? 1 : 0;
        u.e = e; u.pm = mt - tp[e]; u.slot = i; return true;
    }
    DI const char* a_base(const Unit& u) const { return gather ? A : A + (size_t)(tp[u.e] + u.pm) * BM * K * 2; }
    DI const char* b_base(const Unit& u) const { return Bt + (size_t)u.e * bstride + (size_t)u.pn * BM * K * 2; }
};

template <class Epi, class Sched, bool GATHER, bool MIDK, int QM = 0>
DI void gemm_core(LAS unsigned char* lds, const Sched& S, const Epi& E, LAS const unsigned* gtab) {
    const int tid = threadIdx.x, wid = __builtin_amdgcn_readfirstlane(tid >> 6), lane = tid & 63, wr = wid >> 2, wc = wid & 3, fr = lane & 15, fq = lane >> 4;
    const int K = S.K, nt = K / BK;
    unsigned voffA[2], voffB[2]; int RA[2];
#pragma unroll
    for (int i = 0; i < 2; ++i) { int R, C; stage_rc(tid * 16 + i * 8192, R, C); const int Rb = Epi::PERM ? ((R & ~31) + perm32(R & 31)) : R;
        RA[i] = R; voffA[i] = GATHER ? (unsigned)(C * 2) : (unsigned)(R * K + C) * 2u; voffB[i] = (unsigned)(Rb * K + C) * 2u; }
    const size_t kstep = (size_t)(BK * 2);
    const size_t hstep = (size_t)HALF * K * 2;
    const unsigned ldsw = (unsigned)wid * 1024u;
    const int aoff = lds_byte(wr * 64 + fr, fq * 8), boff = lds_byte(wc * 32 + fr, fq * 8);
#define PG8_SA(b, h) (((b) * 2 + (h)) * HTB)
#define PG8_SB(b, h) ((4 + (b) * 2 + (h)) * HTB)
#define PG8_STAGE(bufoff, gbase, voff) do { _Pragma("unroll") for (int _i = 0; _i < 2; ++_i) \
        __builtin_amdgcn_global_load_lds((const unsigned*)((const char*)(gbase) + (voff)[_i]), (LAS unsigned*)(lds + (bufoff) + ldsw + _i * 8192), 16, 0, 0); } while (0)
#define PG8_STAGE_A(bufoff, kb, h, VA) do { if constexpr (GATHER) { PG8_STAGE(bufoff, kb, VA[h]); } else { PG8_STAGE(bufoff, (kb) + (h) * hstep, voffA); } } while (0)
#define PG8_LDA(dst, b, h) do { _Pragma("unroll") for (int m = 0; m < 4; ++m) _Pragma("unroll") for (int k = 0; k < 2; ++k) dst[m][k] = *(const LAS bf16x8*)(lds + PG8_SA(b, h) + aoff + m * 2048 + k * 1024); } while (0)
#define PG8_LDB(dst, b, h) do { _Pragma("unroll") for (int n = 0; n < 2; ++n) _Pragma("unroll") for (int k = 0; k < 2; ++k) dst[n][k] = *(const LAS bf16x8*)(lds + PG8_SB(b, h) + boff + n * 2048 + k * 1024); } while (0)
#define PG8_MMA(ai, bj, At, Bt) do { __builtin_amdgcn_s_setprio(1); _Pragma("unroll") for (int m = 0; m < 4; ++m) _Pragma("unroll") for (int n = 0; n < 2; ++n) { \
        if constexpr (QM == 1) acc[ai][bj][m][n] = __builtin_amdgcn_mfma_scale_f32_16x16x128_f8f6f4(cat8(Bt[n][0], Bt[n][1]), cat8(At[m][0], At[m][1]), acc[ai][bj][m][n], 0, 0, 0, 0x7f7f7f7f, 0, 0x7f7f7f7f); \
        else if constexpr (QM == 2) { _Pragma("unroll") for (int k = 0; k < 2; ++k) acc[ai][bj][m][n] = __builtin_bit_cast(f32x4, __builtin_amdgcn_mfma_i32_16x16x64_i8(__builtin_bit_cast(v4i32, Bt[n][k]), __builtin_bit_cast(v4i32, At[m][k]), __builtin_bit_cast(v4i32, acc[ai][bj][m][n]), 0, 0, 0)); } \
        else { _Pragma("unroll") for (int k = 0; k < 2; ++k) acc[ai][bj][m][n] = __builtin_amdgcn_mfma_f32_16x16x32_bf16(Bt[n][k], At[m][k], acc[ai][bj][m][n], 0, 0, 0); } } __builtin_amdgcn_s_setprio(0); } while (0)
#define PG8_WAIT_V(n) asm volatile("s_waitcnt vmcnt(" #n ")" ::: "memory")
#define PG8_WAIT_L(n) asm volatile("s_waitcnt lgkmcnt(" #n ")" ::: "memory")
#define PG8_BAR __builtin_amdgcn_s_barrier()
#define PG8_SCHED __builtin_amdgcn_sched_barrier(0)
    Unit cur, nxt; int ui = 0;
    if (!S.next(0, cur)) return;
    f32x4 acc[2][2][4][2];
#pragma unroll
    for (int a = 0; a < 2; ++a)
#pragma unroll
        for (int b = 0; b < 2; ++b)
#pragma unroll
            for (int m = 0; m < 4; ++m)
#pragma unroll
                for (int n = 0; n < 2; ++n) acc[a][b][m][n] = (f32x4){0.f, 0.f, 0.f, 0.f};
    bf16x8 At[4][2], B0[2][2], B1[2][2];
    unsigned va[2][2];
    if constexpr (GATHER) {
#pragma unroll
        for (int h = 0; h < 2; ++h)
#pragma unroll
            for (int i = 0; i < 2; ++i) va[h][i] = gtab[cur.slot * 256 + h * 128 + RA[i]] + voffA[i];
    }
    const char* cA = S.a_base(cur); const char* cB = S.b_base(cur);
    PG8_STAGE(PG8_SB(0, 0), cB, voffB); PG8_STAGE(PG8_SB(0, 1), cB + hstep, voffB); PG8_STAGE_A(PG8_SA(0, 0), cA, 0, va); PG8_STAGE_A(PG8_SA(0, 1), cA, 1, va);
    if (wr == 1) PG8_BAR;
    PG8_WAIT_V(2); PG8_BAR;
    PG8_STAGE(PG8_SB(1, 0), cB + kstep, voffB); PG8_STAGE_A(PG8_SA(1, 0), cA + kstep, 0, va); PG8_STAGE(PG8_SB(1, 1), cB + hstep + kstep, voffB);
    PG8_WAIT_V(6); PG8_BAR;
    for (;;) {
        const bool has_next = S.next(ui + 1, nxt);
        const char* nA = has_next ? S.a_base(nxt) : cA; const char* nB = has_next ? S.b_base(nxt) : cB;
#pragma clang loop unroll(disable)
        for (int t = 0; t < nt; t += 2) {
            const bool last = (t == nt - 2);
            const char* a1 = cA + (size_t)(t + 1) * kstep;
            const char* a2 = last ? nA : cA + (size_t)(t + 2) * kstep; const char* b2 = last ? nB : cB + (size_t)(t + 2) * kstep;
            const char* a3 = a2 + kstep; const char* b3 = b2 + kstep;
            if constexpr (MIDK) { if (t == nt / 2) E.midk(acc, cur, wr, fr); }
            PG8_LDB(B0, 0, 0); PG8_LDB(B1, 0, 1); PG8_SCHED; PG8_LDA(At, 0, 0); PG8_STAGE_A(PG8_SA(1, 1), a1, 1, va);
            if constexpr (GATHER) { if (last && has_next) {
#pragma unroll
                for (int h = 0; h < 2; ++h)
#pragma unroll
                    for (int i = 0; i < 2; ++i) va[h][i] = gtab[nxt.slot * 256 + h * 128 + RA[i]] + voffA[i]; } }
            PG8_WAIT_V(8); PG8_WAIT_L(0); PG8_BAR; PG8_MMA(0, 0, At, B0); PG8_MMA(0, 1, At, B1); PG8_BAR; PG8_SCHED;
            PG8_LDA(At, 0, 1); PG8_STAGE(PG8_SB(0, 0), b2, voffB); PG8_STAGE(PG8_SB(0, 1), b2 + hstep, voffB); PG8_STAGE_A(PG8_SA(0, 0), a2, 0, va);
            PG8_WAIT_V(8); PG8_WAIT_L(0); PG8_BAR; PG8_MMA(1, 0, At, B0); PG8_MMA(1, 1, At, B1); PG8_BAR; PG8_SCHED;
            PG8_LDB(B0, 1, 0); PG8_LDB(B1, 1, 1); PG8_SCHED; PG8_LDA(At, 1, 0); PG8_STAGE_A(PG8_SA(0, 1), a2, 1, va);
            PG8_WAIT_V(8); PG8_WAIT_L(0); PG8_BAR; PG8_MMA(0, 0, At, B0); PG8_MMA(0, 1, At, B1); PG8_BAR; PG8_SCHED;
            PG8_LDA(At, 1, 1); PG8_STAGE(PG8_SB(1, 0), b3, voffB); PG8_STAGE(PG8_SB(1, 1), b3 + hstep, voffB); PG8_STAGE_A(PG8_SA(1, 0), a3, 0, va);
            PG8_WAIT_V(8); PG8_WAIT_L(0); PG8_BAR; PG8_MMA(1, 0, At, B0); PG8_MMA(1, 1, At, B1); PG8_BAR; PG8_SCHED;
        }
        if (wr == 0) PG8_BAR;
        E(acc, cur, wr, wc, fr, fq);
        if (!has_next) break;
#pragma unroll
        for (int a = 0; a < 2; ++a)
#pragma unroll
            for (int b = 0; b < 2; ++b)
#pragma unroll
                for (int m = 0; m < 4; ++m)
#pragma unroll
                    for (int n = 0; n < 2; ++n) acc[a][b][m][n] = (f32x4){0.f, 0.f, 0.f, 0.f};
        cur = nxt; cA = nA; cB = nB; ++ui;
        if (wr == 1) PG8_BAR;
    }
    PG8_WAIT_V(0);
    PG8_BAR;
#undef PG8_SA
#undef PG8_SB
#undef PG8_STAGE
#undef PG8_STAGE_A
#undef PG8_LDA
#undef PG8_LDB
#undef PG8_MMA
#undef PG8_WAIT_V
#undef PG8_WAIT_L
#undef PG8_BAR
#undef PG8_SCHED
}

struct EpiInproj {
    static constexpr bool PERM = true;
    bf16* Z; LAS const f32x2* rt;
    DI void operator()(const f32x4 (&acc)[2][2][4][2], const Unit& u, int wr, int wc, int fr, int fq) const {
        const int row0 = u.pm * BM + wr * 64 + fr, col0 = u.pn * BM + wc * 32 + 8 * fq;
        const int kind = u.pn < 4 ? 0 : (u.pn == 4 ? 1 : (u.pn == 5 ? 2 : 3));
        const float sc = kind == 0 ? C2 : 1.f;
        const bool dorope = (kind <= 1) && (wc == 0);
        float ch[8], cl[8]; const bool odd = (fq & 1) != 0;
        ch[0] = odd ? 2.250790858e-04f : 1.591549367e-01f; cl[0] = odd ? -6.755001072e-12f : 6.420638243e-09f;
        ch[1] = odd ? 9.911730740e-05f : 7.008652389e-02f; cl[1] = odd ? 1.969154007e-12f : -2.302696700e-09f;
        ch[2] = odd ? 4.364795313e-05f : 3.086376376e-02f; cl[2] = odd ? -3.416928741e-13f : -3.597993847e-10f;
        ch[3] = odd ? 1.922110096e-05f : 1.359137055e-02f; cl[3] = odd ? -2.712567042e-13f : 9.086624508e-11f;
        ch[4] = odd ? 8.464330676e-06f : 5.985185504e-03f; cl[4] = odd ? 1.318804142e-13f : 2.087540557e-10f;
        ch[5] = odd ? 3.727408512e-06f : 2.635675948e-03f; cl[5] = odd ? 9.029300745e-14f : -4.944578774e-11f;
        ch[6] = odd ? 1.641426252e-06f : 1.160663669e-03f; cl[6] = odd ? 1.098673646e-14f : -2.775752544e-11f;
        ch[7] = odd ? 7.228293271e-07f : 5.111175124e-04f; cl[7] = odd ? -2.017673985e-14f : -7.822671330e-12f;
#pragma unroll
        for (int ai = 0; ai < 2; ++ai)
#pragma unroll
            for (int m = 0; m < 4; ++m) { const int rl = ai * HALF + wr * 64 + m * 16 + fr; bf16* rowp = Z + (size_t)(u.pm * BM + rl) * INW + col0;
                const f32x2 te = rt[u.slot * 256 + rl]; const float dq = te.x;
                f32x4 cs[2], sn[2];
                if (dorope) { const float p = te.y;
#pragma unroll
                    for (int n = 0; n < 2; ++n)
#pragma unroll
                        for (int j = 0; j < 4; ++j) { const int k = 4 * n + j; const float r = p * ch[k], e = __builtin_fmaf(p, ch[k], -r), x = __builtin_amdgcn_fractf(r) + __builtin_fmaf(p, cl[k], e);
                            cs[n][j] = __builtin_amdgcn_cosf(x); sn[n][j] = __builtin_amdgcn_sinf(x); }
                }
#pragma unroll
                for (int bj = 0; bj < 2; ++bj) { f32x4 v[2] = {acc[ai][bj][m][0], acc[ai][bj][m][1]};
                    if constexpr (INP_I8) { _Pragma("unroll") for (int n = 0; n < 2; ++n) { const v4i32 iv = __builtin_bit_cast(v4i32, v[n]); v[n] = (f32x4){(float)iv[0], (float)iv[1], (float)iv[2], (float)iv[3]} * dq; } }
                    if (kind == 3) {
#pragma unroll
                        for (int n = 0; n < 2; ++n) { f32x2 a = gelu_pk((f32x2){v[n][0], v[n][1]}), b = gelu_pk((f32x2){v[n][2], v[n][3]}); v[n] = (f32x4){a.x, a.y, b.x, b.y}; }
                    } else if (dorope) {
#pragma unroll
                        for (int n = 0; n < 2; ++n)
#pragma unroll
                            for (int j = 0; j < 4; ++j) { const float mine = v[n][j], other = xother32(mine);
                                v[n][j] = (fq < 2) ? (mine * cs[n][j] - other * sn[n][j]) : (mine * cs[n][j] + other * sn[n][j]); }
                    }
                    v[0] = v[0] * sc; v[1] = v[1] * sc;
                    u32x4 w; w.x = cvt_pk_bf16(v[0][0], v[0][1]); w.y = cvt_pk_bf16(v[0][2], v[0][3]); w.z = cvt_pk_bf16(v[1][0], v[1][1]); w.w = cvt_pk_bf16(v[1][2], v[1][3]);
                    *(u32x4*)(rowp + bj * HALF) = w; } }
    }
};
struct EpiOutproj {
    static constexpr bool PERM = true;
    bf16* MIX; LAS const f32x2* rr;
    DI void midk(f32x4 (&acc)[2][2][4][2], const Unit& u, int wr, int fr) const {
#pragma unroll
        for (int ai = 0; ai < 2; ++ai)
#pragma unroll
            for (int m = 0; m < 4; ++m) { const float s = rr[u.slot * 256 + ai * HALF + wr * 64 + m * 16 + fr].x;
#pragma unroll
                for (int bj = 0; bj < 2; ++bj)
#pragma unroll
                    for (int n = 0; n < 2; ++n) acc[ai][bj][m][n] = acc[ai][bj][m][n] * s; }
    }
    DI void operator()(const f32x4 (&acc)[2][2][4][2], const Unit& u, int wr, int wc, int fr, int fq) const {
        const int col0 = u.pn * BM + wc * 32 + 8 * fq;
#pragma unroll
        for (int ai = 0; ai < 2; ++ai)
#pragma unroll
            for (int m = 0; m < 4; ++m) { const int rl = ai * HALF + wr * 64 + m * 16 + fr; const float s = rr[u.slot * 256 + rl].y * (OUT_F8 ? 1.f / (W8_SCALE * YA_SCALE) : 1.f); bf16* rowp = MIX + (size_t)(u.pm * BM + rl) * D + col0;
#pragma unroll
                for (int bj = 0; bj < 2; ++bj) { const f32x4 v0 = acc[ai][bj][m][0] * s, v1 = acc[ai][bj][m][1] * s;
                    u32x4 w; w.x = cvt_pk_bf16(v0[0], v0[1]); w.y = cvt_pk_bf16(v0[2], v0[3]); w.z = cvt_pk_bf16(v1[0], v1[1]); w.w = cvt_pk_bf16(v1[2], v1[3]);
                    *(u32x4*)(rowp + bj * HALF) = w; } }
    }
};
struct EpiGateUp {
    static constexpr bool PERM = true;
    unsigned char* HID; LAS const float* wtab; LAS const int* tp;
    DI void operator()(const f32x4 (&acc)[2][2][4][2], const Unit& u, int wr, int wc, int fr, int fq) const {
        const int col0 = u.pn * HALF + wc * 32 + 8 * fq; const size_t rt = (size_t)(tp[u.e] + u.pm) * BM;
        constexpr float in_sc = MOE_FP8 ? 1.f / W8_SCALE : 1.f, out_sc = MOE_FP8 ? H8_SCALE : 1.f;
#pragma unroll
        for (int ai = 0; ai < 2; ++ai)
#pragma unroll
            for (int mp = 0; mp < 2; ++mp) { u32x2 pk8[2]; u32x4 pk16[2];
#pragma unroll
                for (int q = 0; q < 2; ++q) { const int m = 2 * mp + q; const int rl = ai * HALF + wr * 64 + m * 16 + fr; const float w = wtab[u.slot * 256 + rl] * out_sc; f32x4 o[2];
#pragma unroll
                    for (int n = 0; n < 2; ++n)
#pragma unroll
                        for (int j = 0; j < 4; ++j) { const float g = acc[ai][0][m][n][j] * in_sc, up = acc[ai][1][m][n][j] * in_sc; o[n][j] = g * __builtin_amdgcn_rcpf(1.f + __builtin_amdgcn_exp2f(-g * LOG2E)) * up * w; }
                    if constexpr (MOE_FP8) { pk8[q].x = pack4_fp8(o[0][0], o[0][1], o[0][2], o[0][3]); pk8[q].y = pack4_fp8(o[1][0], o[1][1], o[1][2], o[1][3]); }
                    else { pk16[q].x = cvt_pk_bf16(o[0][0], o[0][1]); pk16[q].y = cvt_pk_bf16(o[0][2], o[0][3]); pk16[q].z = cvt_pk_bf16(o[1][0], o[1][1]); pk16[q].w = cvt_pk_bf16(o[1][2], o[1][3]); } }
                const int rl0 = ai * HALF + wr * 64 + (2 * mp) * 16 + fr;
                if constexpr (MOE_FP8) {
                    const u32x4 w16 = pair16(pk8[0], pk8[1]); const int odd = fq & 1;
                    *(u32x4*)(HID + (rt + rl0 + 16 * odd) * FF + col0 - 8 * odd) = w16; }
                else { *(u32x4*)((bf16*)HID + (rt + rl0) * FF + col0) = pk16[0]; *(u32x4*)((bf16*)HID + (rt + rl0 + 16) * FF + col0) = pk16[1]; } }
    }
};
struct EpiDown {
    static constexpr bool PERM = true;
    unsigned char* YK; LAS const unsigned* dtab;
    DI void operator()(const f32x4 (&acc)[2][2][4][2], const Unit& u, int wr, int wc, int fr, int fq) const {
        const int col0 = u.pn * BM + wc * 32 + 8 * fq; constexpr float sc = (MOE_FP8 ? 1.f / (W8_SCALE * H8_SCALE) : 1.f) * (YK_FP8 ? Y8_SCALE : 1.f);
#pragma unroll
        for (int ai = 0; ai < 2; ++ai)
#pragma unroll
            for (int m = 0; m < 4; ++m) { const int rl = ai * HALF + wr * 64 + m * 16 + fr; const unsigned dst = dtab[u.slot * 256 + rl];
                if constexpr (YK_FP8) { u32x2 w[2];
#pragma unroll
                    for (int bj = 0; bj < 2; ++bj) { const f32x4 v0 = acc[ai][bj][m][0] * sc, v1 = acc[ai][bj][m][1] * sc; w[bj].x = pack4_fp8(v0[0], v0[1], v0[2], v0[3]); w[bj].y = pack4_fp8(v1[0], v1[1], v1[2], v1[3]); }
                    const u32x4 w16 = pair16(w[0], w[1]); const int odd = fq & 1;
                    if (dst != 0xffffffffu) *(u32x4*)(YK + (size_t)dst * D + col0 - 8 * odd + HALF * odd) = w16;
                } else { if (dst != 0xffffffffu) {
#pragma unroll
                    for (int bj = 0; bj < 2; ++bj) { const f32x4 v0 = acc[ai][bj][m][0] * sc, v1 = acc[ai][bj][m][1] * sc;
                        u32x4 w; w.x = cvt_pk_bf16(v0[0], v0[1]); w.y = cvt_pk_bf16(v0[2], v0[3]); w.z = cvt_pk_bf16(v1[0], v1[1]); w.w = cvt_pk_bf16(v1[2], v1[3]);
                        *(u32x4*)((bf16*)YK + (size_t)dst * D + col0 + bj * HALF) = w; } } } }
    }
};
}

#define XB_TMO      128
#define XB_XCNT(j)  (256  + 64 * (j))
#define XB_XSUB(j)  (1280 + 64 * (j))
#define XB_XGEN(j)  (2304 + 64 * (j))
#define XB_TOP      3328
#define XB_TOPGEN   3392
#define XCD_BAR_WORDS 3456
#define XB_SPIN_CAP (1u << 18)
DI unsigned xb_ld(unsigned* p)              { return __hip_atomic_load(p, __ATOMIC_RELAXED, __HIP_MEMORY_SCOPE_AGENT); }
DI unsigned xb_add(unsigned* p, unsigned v) { return __hip_atomic_fetch_add(p, v, __ATOMIC_RELAXED, __HIP_MEMORY_SCOPE_AGENT); }
DI unsigned xb_xcc_id() { return (unsigned)__builtin_amdgcn_s_getreg((3 << 11) | 20) & 0xFu; }
#define XB_SPIN(cond, bar) do { unsigned _sp = 0; while (cond) { __builtin_amdgcn_s_sleep(1); \
    if ((++_sp & 255u) == 0u) { if (xb_ld(&(bar)[XB_TMO])) break; if (_sp > XB_SPIN_CAP) { atomicAdd(&(bar)[XB_TMO], 1u); break; } } } } while (0)
struct XcdBarrier { unsigned* bar; unsigned x; volatile LAS unsigned* st; };
DI XcdBarrier xcd_barrier_post(unsigned* bar, volatile LAS unsigned* st) {
    XcdBarrier b; b.bar = bar; b.x = xb_xcc_id(); b.st = st;
    if (threadIdx.x == 0) (void)xb_add(&bar[XB_XCNT(b.x)], 1u);
    return b;
}
DI void xcd_barrier_complete(unsigned* bar, unsigned x, unsigned& nloc, unsigned& nx) {
    const unsigned G = gridDim.x * gridDim.y * gridDim.z;
    unsigned sum, cnt, mine, sp = 0u;
    for (;;) {
        sum = 0u; cnt = 0u; mine = 0u;
#pragma unroll
        for (unsigned j = 0; j < 16; ++j) { const unsigned c = xb_ld(&bar[XB_XCNT(j)]); sum += c; cnt += (c > 0u) ? 1u : 0u; mine = (j == x) ? c : mine; }
        if (sum == G) break;
        __builtin_amdgcn_s_sleep(1);
        if ((++sp & 255u) == 0u) { if (xb_ld(&bar[XB_TMO])) break; if (sp > XB_SPIN_CAP) { atomicAdd(&bar[XB_TMO], 1u); break; } }
    }
    nloc = mine > 0u ? mine : 1u; nx = cnt > 0u ? cnt : 1u;
}
DI void xcd_barrier(const XcdBarrier& b) {
    asm volatile("s_waitcnt vmcnt(0)" ::: "memory");
    __syncthreads();
    if (threadIdx.x == 0) {
        unsigned* bar = b.bar;
        __builtin_amdgcn_s_waitcnt(0);
        unsigned nloc = b.st[0], nx = b.st[1];
        if (nloc == 0u) { xcd_barrier_complete(bar, b.x, nloc, nx); b.st[0] = nloc; b.st[1] = nx; }
        const unsigned old = xb_add(&bar[XB_XSUB(b.x)], 1u);
        const unsigned gen = old / nloc;
        if (old + 1u == (gen + 1u) * nloc) {
            __builtin_amdgcn_fence(__ATOMIC_RELEASE, "agent");
            asm volatile("s_waitcnt vmcnt(0)" ::: "memory");
            const unsigned og = xb_add(&bar[XB_TOP], 1u);
            const unsigned tg = og / nx;
            if (og + 1u == (tg + 1u) * nx) xb_add(&bar[XB_TOPGEN], 1u);
            else XB_SPIN(xb_ld(&bar[XB_TOPGEN]) == tg, bar);
            __builtin_amdgcn_fence(__ATOMIC_ACQUIRE, "agent");
            xb_add(&bar[XB_XGEN(b.x)], 1u);
            asm volatile("s_waitcnt vmcnt(0)" ::: "memory");
        } else {
            XB_SPIN(xb_ld(&bar[XB_XGEN(b.x)]) == gen, bar);
            __builtin_amdgcn_fence(__ATOMIC_ACQUIRE, "agent");
            asm volatile("s_waitcnt vmcnt(0)" ::: "memory");
        }
    }
    __syncthreads();
}

constexpr int NWAVES = 8;
constexpr int RING_BYTES = 131072;
constexpr int TAB_OFF = RING_BYTES;
constexpr int TAB_BYTES = 14336;
constexpr int MISC_OFF = TAB_OFF + TAB_BYTES;
constexpr int LDS_BYTES = 147456;
static_assert(MISC_OFF + 256 <= LDS_BYTES, "LDS map");
constexpr int MAX_SLOTS = 7;

struct Frame { LAS unsigned char* lds; volatile LAS unsigned* MISC; gu32* ctl; int tid, lane, wave, G, gw, NGW; };
struct Ptrs {
    const float *x, *c, *w_ada, *b_ada, *g_mix_pre, *g_mix_post, *w_in, *sink, *gn, *wsp, *bsp, *gg, *w_out, *g_ffn_pre, *g_ffn_post, *w_rg, *b_rg, *w_re, *b_re, *w_gate, *w_up, *w_down;
    const int* pos; float* out;
    float *mod, *rope, *ssp, *lw, *wrgT, *wreT, *asc; unsigned* list; unsigned* ctlcnt; unsigned* wmaxw; bf16 *MIX, *HB, *wsb, *WinT, *WoT, *WguT, *WdT, *A, *Z, *Y, *HID, *YK;
};
constexpr int I_IN = 32 * 112, I_OUT = 32 * 64, I_E = 1024, NITEMS = I_IN + I_OUT + 3 * NE * I_E;
#ifndef CONV_ITEMS
#define CONV_ITEMS 12288
#endif
constexpr int I_DOWN0 = I_IN + I_OUT + 2 * NE * I_E;
constexpr int P0_SPLIT = I_DOWN0 - CONV_ITEMS;
DI int conv_wgs(int G) { return (G == 256) ? 32 : 0; }
DI int conv_split(int G) { return conv_wgs(G) ? P0_SPLIT : NITEMS; }
struct ItemDesc { const float* W; bf16* WT; const float* kscale; int K, N, k0, n0, out_row0, f8; float qs; };
DI ItemDesc decode_item(const Ptrs& P, int it) {
    ItemDesc d; int r = it; d.kscale = nullptr; d.f8 = 0; d.qs = 1.f;
    if (r < I_IN) { d.W = P.w_in; d.WT = P.WinT; d.K = D; d.N = INW; d.k0 = 64 * (r / 112); d.n0 = 32 * (r % 112); d.out_row0 = d.n0;
        if (INP_I8) { d.f8 = 2; d.qs = 127.f / fmaxf(__uint_as_float(__hip_atomic_load(P.wmaxw, RLX_AGENT)), 1e-30f); } return d; } r -= I_IN;
    if (r < I_OUT) { d.W = P.w_out; d.WT = P.WoT; d.K = D; d.N = D; d.k0 = 64 * (r / 64); d.n0 = 32 * (r % 64); d.out_row0 = d.n0; d.kscale = P.gg; if (OUT_F8) d.f8 = 1; return d; } r -= I_OUT;
    const int which = r / (NE * I_E); r -= which * NE * I_E; const int e = r / I_E; r -= e * I_E; d.f8 = MOE_FP8;
    if (which < 2) { d.W = (which ? P.w_up : P.w_gate) + (size_t)e * D * FF; d.WT = P.WguT + (size_t)e * 2048 * (MOE_FP8 ? 1024 : 2048); d.K = D; d.N = FF; d.k0 = 64 * (r / 32); d.n0 = 32 * (r % 32); d.out_row0 = (d.n0 >> 7) * 256 + (d.n0 & 127) + which * 128; }
    else { d.W = P.w_down + (size_t)e * FF * D; d.WT = P.WdT + (size_t)e * 2048 * (MOE_FP8 ? 512 : 1024); d.K = FF; d.N = D; d.k0 = 64 * (r / 64); d.n0 = 32 * (r % 64); d.out_row0 = d.n0; }
    return d;
}
DI void item_load(const ItemDesc& d, f32x4 (&v)[8], int lane) {
    const float* p = d.W + (size_t)(d.k0 + (lane >> 3)) * d.N + d.n0 + 4 * (lane & 7);
#pragma unroll
    for (int i = 0; i < 8; ++i) v[i] = __builtin_nontemporal_load((const GAS f32x4*)(p + (size_t)(8 * i) * d.N));
}
DI void item_finish(const ItemDesc& d, const f32x4 (&v)[8], LAS float* scr, int lane) {
    const int kr = lane >> 3, q = lane & 7;
#pragma unroll
    for (int i = 0; i < 8; ++i) { f32x4 x = v[i]; if (d.kscale) x = x * d.kscale[d.k0 + 8 * i + kr]; LAS float* w = scr + (8 * i + kr) * 33 + 4 * q; w[0] = x.x; w[1] = x.y; w[2] = x.z; w[3] = x.w; }
    LDS_WAIT(); asm volatile("" ::: "memory");
    const int c = lane & 7;
    if (d.f8 == 2) {
#pragma unroll
        for (int j = 0; j < 4; ++j) { const int n = (lane >> 3) + 8 * j; const LAS float* s = scr + (8 * c) * 33 + n; const float q = d.qs;
            u32x2 o; o.x = pack4_i8(clamp127(s[0 * 33] * q), clamp127(s[1 * 33] * q), clamp127(s[2 * 33] * q), clamp127(s[3 * 33] * q)); o.y = pack4_i8(clamp127(s[4 * 33] * q), clamp127(s[5 * 33] * q), clamp127(s[6 * 33] * q), clamp127(s[7 * 33] * q));
            *(GAS u32x2*)((unsigned char*)d.WT + (size_t)(d.out_row0 + n) * d.K + d.k0 + 8 * c) = o; }
    } else if (d.f8) {
#pragma unroll
        for (int j = 0; j < 4; ++j) { const int n = (lane >> 3) + 8 * j; const LAS float* s = scr + (8 * c) * 33 + n;
            u32x2 o; o.x = pack4_fp8(s[0 * 33] * W8_SCALE, s[1 * 33] * W8_SCALE, s[2 * 33] * W8_SCALE, s[3 * 33] * W8_SCALE); o.y = pack4_fp8(s[4 * 33] * W8_SCALE, s[5 * 33] * W8_SCALE, s[6 * 33] * W8_SCALE, s[7 * 33] * W8_SCALE);
            __builtin_nontemporal_store(o, (GAS u32x2*)((unsigned char*)d.WT + (size_t)(d.out_row0 + n) * d.K + d.k0 + 8 * c)); }
    } else {
#pragma unroll
        for (int j = 0; j < 4; ++j) { const int n = (lane >> 3) + 8 * j; const LAS float* s = scr + (8 * c) * 33 + n;
            u32x4 o; o.x = cvtpk_s(s[0 * 33], s[1 * 33]); o.y = cvtpk_s(s[2 * 33], s[3 * 33]); o.z = cvtpk_s(s[4 * 33], s[5 * 33]); o.w = cvtpk_s(s[6 * 33], s[7 * 33]);
            *(GAS u32x4*)(d.WT + (size_t)(d.out_row0 + n) * d.K + d.k0 + 8 * c) = o; }
    }
    LDS_WAIT(); asm volatile("" ::: "memory");
}
DI void convert_range(const Ptrs& P, int first, int end, int stride, LAS float* scr, int lane) {
    int it = first; if (it >= end) return;
    ItemDesc d = decode_item(P, it); f32x4 cur[8]; item_load(d, cur, lane);
    for (;;) {
        const int nit = it + stride; const bool has = nit < end; ItemDesc nd = d; f32x4 nx[8];
        if (has) { nd = decode_item(P, nit); item_load(nd, nx, lane); }
        item_finish(d, cur, scr, lane);
        if (!has) break;
        d = nd; it = nit;
#pragma unroll
        for (int i = 0; i < 8; ++i) cur[i] = nx[i];
    }
}
DI float modv(const Ptrs& P, int b, int idx) { const float* m = P.mod + b * MODW + idx; return ((m[0] + m[NB * MODW]) + (m[2 * NB * MODW] + m[3 * NB * MODW])) + P.b_ada[idx]; }
DI void p0_prologue(Frame& F, const Ptrs& P) {
    LAS float* ca = (LAS float*)F.lds; LAS float* PP = (LAS float*)(F.lds + 65536);
    const int kg = F.tid >> 4, c4 = F.tid & 15; constexpr int NITM = 4 * (MODW / 64), NSCAN = D * INW / 4;
    const int gt = F.gw * 64 + F.lane, NGT = F.NGW * 64;
    f32x4 cv[8];
#pragma unroll
    for (int j = 0; j < 8; ++j) cv[j] = *(const GAS f32x4*)(P.c + 4 * (F.tid + NWAVES * 64 * j));
#define P0_LOADW(W_, ITEM_) do { const int chunk_ = (ITEM_) % (MODW / 64), kq_ = (ITEM_) / (MODW / 64); const float* wp_ = P.w_ada + (size_t)(512 * kq_ + kg) * MODW + 64 * chunk_ + 4 * c4; \
        _Pragma("unroll") for (int i = 0; i < 16; ++i) W_[i] = __builtin_nontemporal_load((const GAS f32x4*)(wp_ + (size_t)(32 * i) * MODW)); } while (0)
    int item = blockIdx.x; f32x4 w[16];
    if (item < NITM) P0_LOADW(w, item);
    float t_rg = 0.f, t_re = 0.f, t_sb = 0.f;
    if (gt < NG * D) t_rg = P.w_rg[(gt % D) * NG + gt / D];
    if (gt < NE * D) t_re = P.w_re[(gt % D) * NE + gt / D];
    if (gt < GH * CH * CH) t_sb = P.wsp[gt];
    const GAS f32x4* wsc = (const GAS f32x4*)P.w_in; int sbase = gt; f32x4 sv[7]; bool spend = false; float wm = 0.f;
#define P0_SCAN_ISSUE() do { _Pragma("unroll") for (int j = 0; j < 7; ++j) { const int idx_ = sbase + j * NGT; sv[j] = (INP_I8 && idx_ < NSCAN) ? wsc[idx_] : (f32x4){0.f, 0.f, 0.f, 0.f}; } sbase += 7 * NGT; spend = true; } while (0)
#define P0_SCAN_EAT() do { _Pragma("unroll") for (int j = 0; j < 7; ++j) wm = fmaxf(wm, fmaxf(fmaxf(fabsf(sv[j].x), fabsf(sv[j].y)), fmaxf(fabsf(sv[j].z), fabsf(sv[j].w)))); spend = false; } while (0)
    if (INP_I8 && sbase < NSCAN) P0_SCAN_ISSUE();
    asm volatile("" ::: "memory");
#pragma unroll
    for (int j = 0; j < 8; ++j) { f32x4 o; o.x = cv[j].x / (1.f + expf(-cv[j].x)); o.y = cv[j].y / (1.f + expf(-cv[j].y)); o.z = cv[j].z / (1.f + expf(-cv[j].z)); o.w = cv[j].w / (1.f + expf(-cv[j].w)); *(LAS f32x4*)(ca + 4 * (F.tid + NWAVES * 64 * j)) = o; }
    __syncthreads();
    while (item < NITM) {
        const int nitem = item + F.G; const bool has = nitem < NITM; f32x4 wn[16];
        if (has) P0_LOADW(wn, nitem);
        asm volatile("" ::: "memory");
        const int chunk = item % (MODW / 64), kq = item / (MODW / 64), kbase = 512 * kq;
        f32x4 acc[NB];
#pragma unroll
        for (int b = 0; b < NB; ++b) acc[b] = (f32x4){0.f, 0.f, 0.f, 0.f};
#pragma unroll
        for (int i = 0; i < 16; ++i) { const int k = kbase + kg + 32 * i;
#pragma unroll
            for (int b = 0; b < NB; ++b) acc[b] += w[i] * ca[b * D + k]; }
#pragma unroll
        for (int b = 0; b < NB; ++b) *(LAS f32x4*)(PP + (kg * 8 + b) * 64 + 4 * c4) = acc[b];
        __syncthreads();
        { const int b = F.tid >> 6, col = F.tid & 63; float sacc = 0.f;
#pragma unroll 8
          for (int k2 = 0; k2 < 32; ++k2) sacc += PP[(k2 * 8 + b) * 64 + col];
          P.mod[(size_t)kq * NB * MODW + b * MODW + 64 * chunk + col] = sacc; }
        __syncthreads();
        if (spend) { P0_SCAN_EAT(); if (sbase < NSCAN) P0_SCAN_ISSUE(); }
        asm volatile("" ::: "memory");
        if (has) {
#pragma unroll
            for (int i = 0; i < 16; ++i) w[i] = wn[i]; }
        item = nitem;
    }
    while (spend) { P0_SCAN_EAT(); if (sbase < NSCAN) P0_SCAN_ISSUE(); }
#undef P0_LOADW
#undef P0_SCAN_ISSUE
#undef P0_SCAN_EAT
    if constexpr (INP_I8) {
#pragma unroll
        for (int o = 1; o < 64; o <<= 1) wm = fmaxf(wm, __shfl_xor(wm, o));
        if (F.lane == 0) atomicMax(P.wmaxw, __float_as_uint(wm)); }
    if (gt < NG * D) P.wrgT[gt] = t_rg;
    if (gt < NE * D) P.wreT[gt] = t_re;
    if (gt < GH * CH * CH) P.wsb[gt] = f2bf(t_sb);
    for (int i = gt + NGT; i < NG * D; i += NGT) { const int g = i / D, k = i % D; P.wrgT[i] = P.w_rg[k * NG + g]; }
    for (int i = gt + NGT; i < NE * D; i += NGT) { const int ge = i / D, k = i % D; P.wreT[i] = P.w_re[k * NE + ge]; }
    for (int i = gt + NGT; i < GH * CH * CH; i += NGT) P.wsb[i] = f2bf(P.wsp[i]);
}
DI void p1_norm(Frame& F, const Ptrs& P) {
    LAS float* G1 = (LAS float*)F.lds; LAS float* H1 = G1 + D; constexpr int RPB = 64; const int lane = F.lane;
    for (int blk = blockIdx.x; blk < T / RPB; blk += F.G) {
        const int row_base = blk * RPB, b = row_base / S;
        f32x4 cur[8];
        { const GAS f32x4* xr = (const GAS f32x4*)(P.x + (size_t)(row_base + F.wave) * D) + lane;
#pragma unroll
          for (int j = 0; j < 8; ++j) cur[j] = __builtin_nontemporal_load(xr + 64 * j); }
        __syncthreads();
        for (int i = F.tid; i < D; i += NWAVES * 64) { G1[i] = P.g_mix_pre[i] * (1.f + modv(P, b, D + i)); H1[i] = modv(P, b, i); }
        __syncthreads();
        for (int rr = F.wave; rr < RPB; rr += NWAVES) {
            const int row = row_base + rr; f32x4 nxt[8];
            if (rr + NWAVES < RPB) { const GAS f32x4* xr = (const GAS f32x4*)(P.x + (size_t)(row + NWAVES) * D) + lane;
#pragma unroll
                for (int j = 0; j < 8; ++j) nxt[j] = __builtin_nontemporal_load(xr + 64 * j); }
            float ss = 0.f;
#pragma unroll
            for (int j = 0; j < 8; ++j) ss += (cur[j].x * cur[j].x + cur[j].y * cur[j].y) + (cur[j].z * cur[j].z + cur[j].w * cur[j].w);
            const float r = rsqrtf(wave_sum(ss) * (1.f / D) + EPS);
            if constexpr (INP_I8) {
                f32x4 av[8]; float amax = 1e-30f;
#pragma unroll
                for (int j = 0; j < 8; ++j) { const int col = 4 * lane + 256 * j; const f32x4 g = *(const LAS f32x4*)(G1 + col), sh = *(const LAS f32x4*)(H1 + col);
                    av[j] = cur[j] * r * g + sh; amax = fmaxf(amax, fmaxf(fmaxf(fabsf(av[j].x), fabsf(av[j].y)), fmaxf(fabsf(av[j].z), fabsf(av[j].w)))); }
#pragma unroll
                for (int o = 1; o < 64; o <<= 1) amax = fmaxf(amax, __shfl_xor(amax, o));
                const float qs = 127.f / amax; if (lane == 0) P.asc[row] = amax * (1.f / 127.f);
                GAS unsigned* o4 = (GAS unsigned*)((unsigned char*)P.A + (size_t)row * D) + lane;
#pragma unroll
                for (int j = 0; j < 8; ++j) o4[64 * j] = pack4_i8(av[j].x * qs, av[j].y * qs, av[j].z * qs, av[j].w * qs);
            } else {
            GAS u32x2* o8 = (GAS u32x2*)(P.A + (size_t)row * D) + lane;
#pragma unroll
            for (int j = 0; j < 8; ++j) { const int col = 4 * lane + 256 * j; const f32x4 g = *(const LAS f32x4*)(G1 + col), sh = *(const LAS f32x4*)(H1 + col);
                const f32x4 a = cur[j] * r * g + sh; u32x2 w; w.x = cvt_pk_bf16(a.x, a.y); w.y = cvt_pk_bf16(a.z, a.w); o8[64 * j] = w; }
            }
#pragma unroll
            for (int j = 0; j < 8; ++j) cur[j] = nxt[j];
        }
    }
    __syncthreads();
    { LAS float* scr = (LAS float*)(F.lds + F.wave * 16384); convert_range(P, F.gw, conv_split(F.G), F.NGW, scr, F.lane); }
}
DI int crow(int r, int hi) { return (r & 3) + 8 * (r >> 2) + 4 * hi; }
#define KSWZ(row, colB) ((row) * 256 + ((colB) ^ (((row) & 7) << 4)))
DI int vimg_off(int row, int ch) { return 2048 * (row >> 3) + 512 * (ch >> 2) + 64 * (row & 7) + 16 * ((ch & 3) ^ ((row >> 2) & 3)); }
DI s16x4 vtr(LAS const unsigned char* p) { return __builtin_bit_cast(s16x4, __builtin_amdgcn_ds_read_tr16_b64_v4i16((LAS v4i16_t*)p)); }
DI bf16x8 pack8(const f32x16& x, int s) {
    u32x4 p; p.x = cvtpk_s(x[8 * s + 0], x[8 * s + 1]); p.y = cvtpk_s(x[8 * s + 2], x[8 * s + 3]); p.z = cvtpk_s(x[8 * s + 4], x[8 * s + 5]); p.w = cvtpk_s(x[8 * s + 6], x[8 * s + 7]);
    return __builtin_bit_cast(bf16x8, p);
}
#define MFMA32(a, b, c) __builtin_amdgcn_mfma_f32_32x32x16_bf16((a), (b), (c), 0, 0, 0)
DI void attn_unit(Frame& F, const Ptrs& P, int b, int kvh, int pb) {
    const int tid = F.tid, lane = F.lane, w = F.wave, r32 = lane & 31, h = lane >> 5;
    const int hq = kvh * 4 + (w >> 1), p0 = pb * 64, qpos = p0 + 32 * (w & 1) + r32; const size_t trow = (size_t)b * S + qpos;
    LAS unsigned char* Kb = F.lds; LAS unsigned char* Vb = F.lds + 32768;
    bf16x8 qr[8]; { const bf16* qp = P.Z + trow * INW + OQ + hq * HD + 8 * h;
#pragma unroll
        for (int d0 = 0; d0 < 8; ++d0) qr[d0] = *(const bf16x8*)(qp + 16 * d0); }
    f32x16 o[4];
#pragma unroll
    for (int d0 = 0; d0 < 4; ++d0)
#pragma unroll
        for (int r = 0; r < 16; ++r) o[d0][r] = 0.f;
    float m_run = P.sink[hq] * LOG2E, l_run = 1.f;
    const int j_lo = p0 >= 128 ? 0 : (128 - p0) / 64, j_hi = (S - 64 - p0 + 128) / 64 < 4 ? (S - 64 - p0 + 128) / 64 : 4;
    const int sr = tid >> 4, sc = tid & 15;
    const bf16* kg = P.Z + ((size_t)b * S) * INW + OK_ + kvh * HD + sc * 8; const bf16* vg = P.Z + ((size_t)b * S) * INW + OV + kvh * HD + sc * 8;
    const int kst0 = KSWZ(sr, sc * 16), kst1 = KSWZ(sr + 32, sc * 16), vst0 = vimg_off(sr, sc), vst1 = vimg_off(sr + 32, sc);
    const int q4 = (lane & 15) >> 2, p4 = lane & 3, g16 = (lane >> 4) & 1;
    const int vb0 = 64 * (4 * h + q4) + 16 * ((2 * g16 + (p4 >> 1)) ^ h) + 8 * (p4 & 1), vb1 = 2048 + 64 * (4 * h + q4) + 16 * ((2 * g16 + (p4 >> 1)) ^ (h + 2)) + 8 * (p4 & 1);
    bf16x8 sk0, sk1, sv0, sv1;
#define ATT_LOAD(j) do { const size_t r0 = (size_t)(p0 - 128 + 64 * (j) + sr) * INW; sk0 = *(const bf16x8*)(kg + r0); sk1 = *(const bf16x8*)(kg + r0 + (size_t)32 * INW); sv0 = *(const bf16x8*)(vg + r0); sv1 = *(const bf16x8*)(vg + r0 + (size_t)32 * INW); } while (0)
#define ATT_WRITE(bi) do { *(LAS bf16x8*)(Kb + (bi) * 16384 + kst0) = sk0; *(LAS bf16x8*)(Kb + (bi) * 16384 + kst1) = sk1; *(LAS bf16x8*)(Vb + (bi) * 16384 + vst0) = sv0; *(LAS bf16x8*)(Vb + (bi) * 16384 + vst1) = sv1; } while (0)
    ATT_LOAD(j_lo); ATT_WRITE(0);
    __syncthreads();
    for (int j = j_lo; j <= j_hi; ++j) {
        const int cur = (j - j_lo) & 1;
        if (j < j_hi) ATT_LOAD(j + 1);
        LAS const unsigned char* Kc = Kb + cur * 16384; LAS const unsigned char* Vc = Vb + cur * 16384;
        f32x16 s0, s1;
#pragma unroll
        for (int r = 0; r < 16; ++r) { s0[r] = 0.f; s1[r] = 0.f; }
#pragma unroll
        for (int d0 = 0; d0 < 8; ++d0) { const bf16x8 a0 = *(const LAS bf16x8*)(Kc + KSWZ(r32, (d0 * 16 + h * 8) * 2)); s0 = MFMA32(a0, qr[d0], s0); }
#pragma unroll
        for (int d0 = 0; d0 < 8; ++d0) { const bf16x8 a1 = *(const LAS bf16x8*)(Kc + KSWZ(32 + r32, (d0 * 16 + h * 8) * 2)); s1 = MFMA32(a1, qr[d0], s1); }
        if (j == 0 || j == 4) { const int kbase = p0 - 128 + 64 * j - qpos;
#pragma unroll
            for (int r = 0; r < 16; ++r) { const int d0 = kbase + crow(r, h), d1 = d0 + 32; if (d0 < -WIN || d0 > WIN) s0[r] = -1e30f; if (d1 < -WIN || d1 > WIN) s1[r] = -1e30f; } }
        float pmax = s0[0];
#pragma unroll
        for (int r = 1; r < 16; ++r) pmax = fmaxf(pmax, s0[r]);
#pragma unroll
        for (int r = 0; r < 16; ++r) pmax = fmaxf(pmax, s1[r]);
        pmax = xmax32(pmax);
        pmax -= m_run;
        float dlt = 0.f;
        if (__any(pmax > 8.f)) { dlt = fmaxf(pmax, 0.f); const float alpha = __builtin_amdgcn_exp2f(-dlt); l_run *= alpha;
#pragma unroll
            for (int d0 = 0; d0 < 4; ++d0)
#pragma unroll
                for (int r = 0; r < 16; ++r) o[d0][r] *= alpha; }
        const float mn = m_run + dlt; m_run = mn;
        float ps = 0.f;
#pragma unroll
        for (int r = 0; r < 16; ++r) { s0[r] = __builtin_amdgcn_exp2f(s0[r] - mn); s1[r] = __builtin_amdgcn_exp2f(s1[r] - mn); ps += s0[r] + s1[r]; }
        ps = xsum32(ps); l_run += ps;
        const bf16x8 pb0 = pack8(s0, 0), pb1 = pack8(s0, 1), pb2 = pack8(s1, 0), pb3 = pack8(s1, 1);
#pragma unroll
        for (int d0 = 0; d0 < 4; ++d0) {
#define ATT_VF(ks) ({ const s16x4 lo_ = vtr(Vc + vb0 + 4096 * (ks) + 512 * d0), hi_ = vtr(Vc + vb1 + 4096 * (ks) + 512 * d0); (bf16x8){lo_[0], lo_[1], lo_[2], lo_[3], hi_[0], hi_[1], hi_[2], hi_[3]}; })
            const bf16x8 v0 = ATT_VF(0), v1 = ATT_VF(1), v2 = ATT_VF(2), v3 = ATT_VF(3);
            o[d0] = MFMA32(v0, pb0, o[d0]); o[d0] = MFMA32(v1, pb1, o[d0]); o[d0] = MFMA32(v2, pb2, o[d0]); o[d0] = MFMA32(v3, pb3, o[d0]);
        }
        if (j < j_hi) ATT_WRITE(cur ^ 1);
        __syncthreads();
    }
    const float inv = 1.f / l_run; float ss = 0.f; bf16* yp = P.Y + trow * D + hq * HD + 4 * h;
#pragma unroll
    for (int d0 = 0; d0 < 4; ++d0)
#pragma unroll
        for (int g4 = 0; g4 < 4; ++g4) { const float a = o[d0][4 * g4] * inv, b2 = o[d0][4 * g4 + 1] * inv, c = o[d0][4 * g4 + 2] * inv, d = o[d0][4 * g4 + 3] * inv; ss += (a * a + b2 * b2) + (c * c + d * d);
            if constexpr (OUT_F8) { *(unsigned*)((unsigned char*)P.Y + trow * D + hq * HD + 4 * h + 32 * d0 + 8 * g4) = pack4_fp8(a * YA_SCALE, b2 * YA_SCALE, c * YA_SCALE, d * YA_SCALE); } else { u32x2 wv; wv.x = cvt_pk_bf16(a, b2); wv.y = cvt_pk_bf16(c, d); *(u32x2*)(yp + 32 * d0 + 8 * g4) = wv; } }
    ss = xsum32(ss); if (h == 0) P.ssp[trow * SSPW + hq] = ss;
#undef ATT_LOAD
#undef ATT_WRITE
}
DI void gmlp_phase(Frame& F, const Ptrs& P) {
    constexpr int NGM = NB * (S / CH) * GH;
    const int tid = F.tid, lane = F.lane, w = F.wave, r32 = lane & 31, h = lane >> 5, ch = tid & 15;
    LAS unsigned char* VC = F.lds;
    const int q4 = (lane & 15) >> 2, p4 = lane & 3, g16 = (lane >> 4) & 1;
    const int vb0 = 64 * (4 * h + q4) + 16 * ((2 * g16 + (p4 >> 1)) ^ h) + 8 * (p4 & 1), vb1 = 2048 + 64 * (4 * h + q4) + 16 * ((2 * g16 + (p4 >> 1)) ^ (h + 2)) + 8 * (p4 & 1);
    const int p = 32 * (w & 3) + r32, dp = w >> 2;
    int u = blockIdx.x; if (u >= NGM) return;
    bf16x8 raw[4];
#define GM_DECODE(uu, hh_, t0_) const int hh_ = (uu) % GH; const size_t t0_ = (size_t)((uu) / (GH * (S / CH))) * S + (size_t)(((uu) / GH) % (S / CH)) * CH
#define GM_LOADV(hh_, t0_) do { _Pragma("unroll") for (int i = 0; i < 4; ++i) raw[i] = *(const bf16x8*)(P.Z + ((t0_) + (tid >> 4) + 32 * i) * INW + OVG + (hh_) * HD + 8 * ch); } while (0)
    { GM_DECODE(u, hh0, t00); GM_LOADV(hh0, t00); }
    for (;;) {
        GM_DECODE(u, hh, t0);
        const size_t trow = t0 + p;
        s16x4 uv[2][4]; { const bf16* up = P.Z + trow * INW + OU + hh * HD + 4 * h;
#pragma unroll
            for (int dd = 0; dd < 2; ++dd)
#pragma unroll
                for (int g4 = 0; g4 < 4; ++g4) uv[dd][g4] = *(const s16x4*)(up + 32 * (2 * dp + dd) + 8 * g4); }
        const float bias = P.bsp[hh * CH + p];
        const f32x4 g0 = *(const f32x4*)(P.gn + hh * HD + 8 * ch), g1 = *(const f32x4*)(P.gn + hh * HD + 8 * ch + 4);
#pragma unroll
        for (int i = 0; i < 4; ++i) { const int r = (tid >> 4) + 32 * i;
            float v[8]; float s1 = 0.f;
#pragma unroll
            for (int k = 0; k < 8; ++k) { v[k] = bf2f((bf16)raw[i][k]); s1 += v[k]; }
            s1 = sum16(s1);
            const float mu = s1 * (1.f / 128); float s2 = 0.f;
#pragma unroll
            for (int k = 0; k < 8; ++k) { v[k] -= mu; s2 += v[k] * v[k]; }
            s2 = sum16(s2);
            const float rs = rsqrtf(s2 * (1.f / 128) + EPS);
            u32x4 pk; pk.x = cvt_pk_bf16(v[0] * rs * g0.x, v[1] * rs * g0.y); pk.y = cvt_pk_bf16(v[2] * rs * g0.z, v[3] * rs * g0.w); pk.z = cvt_pk_bf16(v[4] * rs * g1.x, v[5] * rs * g1.y); pk.w = cvt_pk_bf16(v[6] * rs * g1.z, v[7] * rs * g1.w);
            *(LAS u32x4*)(VC + vimg_off(r, ch)) = pk; }
        __syncthreads();
        const int un = u + F.G; const bool has = un < NGM;
        if (has) { GM_DECODE(un, hhn, t0n); GM_LOADV(hhn, t0n); }
        const bf16* wrow = P.wsb + ((size_t)hh * CH + p) * CH + 4 * h;
        f32x16 acc[2];
#pragma unroll
        for (int dd = 0; dd < 2; ++dd)
#pragma unroll
            for (int r = 0; r < 16; ++r) acc[dd][r] = 0.f;
#pragma unroll
        for (int ks = 0; ks < 8; ++ks) { const s16x4 wl = *(const s16x4*)(wrow + 16 * ks), wh = *(const s16x4*)(wrow + 16 * ks + 8);
            const bf16x8 bfrag = (bf16x8){wl[0], wl[1], wl[2], wl[3], wh[0], wh[1], wh[2], wh[3]};
#pragma unroll
            for (int dd = 0; dd < 2; ++dd) { const int d0 = 2 * dp + dd; const s16x4 lo = vtr(VC + vb0 + 4096 * ks + 512 * d0), hi = vtr(VC + vb1 + 4096 * ks + 512 * d0);
                acc[dd] = MFMA32(((bf16x8){lo[0], lo[1], lo[2], lo[3], hi[0], hi[1], hi[2], hi[3]}), bfrag, acc[dd]); } }
        float ss = 0.f; bf16* yp = P.Y + trow * D + AW + hh * HD + 4 * h;
#pragma unroll
        for (int dd = 0; dd < 2; ++dd)
#pragma unroll
            for (int g4 = 0; g4 < 4; ++g4) { const int dof = 32 * (2 * dp + dd) + 8 * g4; const s16x4 u4 = uv[dd][g4];
                const float a = bf2f((bf16)u4[0]) * (acc[dd][4 * g4] + bias), b2 = bf2f((bf16)u4[1]) * (acc[dd][4 * g4 + 1] + bias), c2 = bf2f((bf16)u4[2]) * (acc[dd][4 * g4 + 2] + bias), d2 = bf2f((bf16)u4[3]) * (acc[dd][4 * g4 + 3] + bias);
                ss += (a * a + b2 * b2) + (c2 * c2 + d2 * d2); if constexpr (OUT_F8) { *(unsigned*)((unsigned char*)P.Y + trow * D + AW + hh * HD + 4 * h + dof) = pack4_fp8(a * YA_SCALE, b2 * YA_SCALE, c2 * YA_SCALE, d2 * YA_SCALE); } else { u32x2 wv; wv.x = cvt_pk_bf16(a, b2); wv.y = cvt_pk_bf16(c2, d2); *(u32x2*)(yp + dof) = wv; } }
        ss = xsum32(ss); if (h == 0) P.ssp[trow * SSPW + 8 + hh * 2 + dp] = ss;
        __syncthreads();
        if (!has) break;
        u = un;
    }
#undef GM_DECODE
#undef GM_LOADV
}
DI void p3_mixer(Frame& F, const Ptrs& P) {
    constexpr int NATT = NB * KVH * (S / 64);
    for (int u = blockIdx.x; u < NATT; u += F.G) { const int pb = u % (S / 64), kvh = (u / (S / 64)) % KVH, b = u / ((S / 64) * KVH); attn_unit(F, P, b, kvh, pb); }
    gmlp_phase(F, P);
}
DI void bf4_to_f(const u32x2 a, f32x4& v) { v.x = __uint_as_float(a.x << 16); v.y = __uint_as_float(a.x & 0xffff0000u); v.z = __uint_as_float(a.y << 16); v.w = __uint_as_float(a.y & 0xffff0000u); }
DI void p5_thin(Frame& F, const Ptrs& P) {
    LAS float* A1 = (LAS float*)F.lds; LAS float* A2 = A1 + D; LAS float* A3 = A2 + D; LAS float* WG = A3 + D;
    LAS unsigned* lcnt = (LAS unsigned*)(WG + NG * D); LAS unsigned* lbase = lcnt + NE; LAS unsigned* lent = lbase + NE; LAS float* lwt = (LAS float*)(lent + NE * 128);
    constexpr int RPB = 64; const int lane = F.lane;
    for (int i = F.tid; i < NG * D; i += NWAVES * 64) WG[i] = P.wrgT[i];
    for (int blk = blockIdx.x; blk < T / RPB; blk += F.G) {
        const int row_base = blk * RPB, b = row_base / S;
        u32x2 cm[8]; f32x4 cx[8];
        { const GAS u32x2* mr = (const GAS u32x2*)(P.MIX + (size_t)(row_base + F.wave) * D) + lane; const GAS f32x4* xr = (const GAS f32x4*)(P.x + (size_t)(row_base + F.wave) * D) + lane;
#pragma unroll
          for (int j = 0; j < 8; ++j) { cm[j] = __builtin_nontemporal_load(mr + 64 * j); cx[j] = __builtin_nontemporal_load(xr + 64 * j); } }
        __syncthreads();
        for (int i = F.tid; i < D; i += NWAVES * 64) { A1[i] = modv(P, b, 2 * D + i) * P.g_mix_post[i]; A2[i] = P.g_ffn_pre[i] * (1.f + modv(P, b, 4 * D + i)); A3[i] = modv(P, b, 3 * D + i); }
        if (F.tid < NE) lcnt[F.tid] = 0u;
        __syncthreads();
        for (int rr = F.wave; rr < RPB; rr += NWAVES) {
            const int row = row_base + rr; u32x2 nm[8]; f32x4 nx[8];
            if (rr + NWAVES < RPB) { const GAS u32x2* mr = (const GAS u32x2*)(P.MIX + (size_t)(row + NWAVES) * D) + lane; const GAS f32x4* xr = (const GAS f32x4*)(P.x + (size_t)(row + NWAVES) * D) + lane;
#pragma unroll
                for (int j = 0; j < 8; ++j) { nm[j] = __builtin_nontemporal_load(mr + 64 * j); nx[j] = __builtin_nontemporal_load(xr + 64 * j); } }
            f32x4 v[8]; float ss = 0.f;
#pragma unroll
            for (int j = 0; j < 8; ++j) { bf4_to_f(cm[j], v[j]); ss += (v[j].x * v[j].x + v[j].y * v[j].y) + (v[j].z * v[j].z + v[j].w * v[j].w); }
            float r = rsqrtf(wave_sum(ss) * (1.f / D) + EPS); ss = 0.f;
            GAS u32x2* ho = (GAS u32x2*)(P.HB + (size_t)row * D) + lane;
#pragma unroll
            for (int j = 0; j < 8; ++j) { const f32x4 a1 = *(const LAS f32x4*)(A1 + 4 * lane + 256 * j); v[j] = cx[j] + a1 * (v[j] * r); u32x2 hw; hw.x = cvt_pk_bf16(v[j].x, v[j].y); hw.y = cvt_pk_bf16(v[j].z, v[j].w); __builtin_nontemporal_store(hw, ho + 64 * j); ss += (v[j].x * v[j].x + v[j].y * v[j].y) + (v[j].z * v[j].z + v[j].w * v[j].w); }
            r = rsqrtf(wave_sum(ss) * (1.f / D) + EPS);
            float gl[4] = {0.f, 0.f, 0.f, 0.f}; GAS u32x2* fo = (GAS u32x2*)(P.A + (size_t)row * D) + lane;
#pragma unroll
            for (int j = 0; j < 8; ++j) { const int col = 4 * lane + 256 * j; const f32x4 a2 = *(const LAS f32x4*)(A2 + col), a3 = *(const LAS f32x4*)(A3 + col); v[j] = v[j] * r * a2 + a3;
                if constexpr (MOE_FP8) { ((GAS unsigned*)((unsigned char*)P.A + (size_t)row * D) + lane)[64 * j] = pack4_fp8(v[j].x, v[j].y, v[j].z, v[j].w); } else { u32x2 wv; wv.x = cvt_pk_bf16(v[j].x, v[j].y); wv.y = cvt_pk_bf16(v[j].z, v[j].w); fo[64 * j] = wv; }
#pragma unroll
                for (int g = 0; g < 4; ++g) { const f32x4 wg = *(const LAS f32x4*)(WG + g * D + col); gl[g] += (v[j].x * wg.x + v[j].y * wg.y) + (v[j].z * wg.z + v[j].w * wg.w); } }
            int gi = 0; float gmax = -1e30f;
#pragma unroll
            for (int g = 0; g < 4; ++g) { gl[g] = wave_sum(gl[g]) + P.b_rg[g]; if (gl[g] > gmax) { gmax = gl[g]; gi = g; } }
            float gsum = 0.f;
#pragma unroll
            for (int g = 0; g < 4; ++g) gsum += expf(gl[g] - gmax);
            const float gval = 1.f / gsum;
            float el[4] = {0.f, 0.f, 0.f, 0.f};
#pragma unroll
            for (int e = 0; e < 4; ++e) { const float* we = P.wreT + (size_t)(gi * EPG + e) * D;
#pragma unroll
                for (int j = 0; j < 8; ++j) { const f32x4 wv = *(const f32x4*)(we + 4 * lane + 256 * j); el[e] += (v[j].x * wv.x + v[j].y * wv.y) + (v[j].z * wv.z + v[j].w * wv.w); } }
            int e1 = 0; float m1 = -1e30f;
#pragma unroll
            for (int e = 0; e < 4; ++e) { el[e] = wave_sum(el[e]) + P.b_re[gi * EPG + e]; if (el[e] > m1) { m1 = el[e]; e1 = e; } }
            int e2 = 0; float m2 = -1e30f;
#pragma unroll
            for (int e = 0; e < 4; ++e) if (e != e1 && el[e] > m2) { m2 = el[e]; e2 = e; }
            const float p2 = expf(m2 - m1); const float w1 = gval / (1.f + p2), w2 = gval * p2 / (1.f + p2);
            if (lane == 0) {
                const int ea = gi * EPG + e1, eb = gi * EPG + e2;
                const unsigned pa = __hip_atomic_fetch_add(&lcnt[ea], 1u, __ATOMIC_RELAXED, __HIP_MEMORY_SCOPE_WORKGROUP); lent[ea * 128 + pa] = (unsigned)row * 2u; lwt[ea * 128 + pa] = w1;
                const unsigned pb = __hip_atomic_fetch_add(&lcnt[eb], 1u, __ATOMIC_RELAXED, __HIP_MEMORY_SCOPE_WORKGROUP); lent[eb * 128 + pb] = (unsigned)row * 2u + 1u; lwt[eb * 128 + pb] = w2;
            }
#pragma unroll
            for (int j = 0; j < 8; ++j) { cm[j] = nm[j]; cx[j] = nx[j]; }
        }
        __syncthreads();
        if (F.tid < NE) lbase[F.tid] = atomicAdd((unsigned*)P.ctlcnt + F.tid, lcnt[F.tid]);
        __syncthreads();
        for (int i = F.tid; i < NE * 128; i += NWAVES * 64) { const int e = i >> 7, k = i & 127; if ((unsigned)k < lcnt[e]) { const unsigned dst = lbase[e] + k; P.list[e * T + dst] = lent[i]; P.lw[e * T + dst] = lwt[i]; } }
    }
    __syncthreads();
}
DI void fp8x4_to_f(unsigned a, f32x4& v) { const f32x2 lo = __builtin_amdgcn_cvt_pk_f32_fp8((int)a, false), hi = __builtin_amdgcn_cvt_pk_f32_fp8((int)a, true); v.x = lo.x; v.y = lo.y; v.z = hi.x; v.w = hi.y; }
DI void p8_final(Frame& F, const Ptrs& P) {
    LAS float* A4 = (LAS float*)F.lds; constexpr int RPB = 64; const int lane = F.lane;
    typedef unsigned YT __attribute__((ext_vector_type(YK_FP8 ? 1 : 2)));
    constexpr int YROW = YK_FP8 ? D : 2 * D;
    for (int blk = blockIdx.x; blk < T / RPB; blk += F.G) {
        const int row_base = blk * RPB, b = row_base / S;
        YT c0[8], c1[8]; u32x2 ch[8];
#define P8_LOAD(Y0_, Y1_, H_, ROW_) do { const GAS YT* y0_ = (const GAS YT*)((const unsigned char*)P.YK + (size_t)(2 * (ROW_)) * YROW) + lane; const GAS YT* y1_ = (const GAS YT*)((const unsigned char*)P.YK + (size_t)(2 * (ROW_) + 1) * YROW) + lane; \
            const GAS u32x2* hr_ = (const GAS u32x2*)(P.HB + (size_t)(ROW_) * D) + lane; \
            _Pragma("unroll") for (int j = 0; j < 8; ++j) { Y0_[j] = __builtin_nontemporal_load(y0_ + 64 * j); Y1_[j] = __builtin_nontemporal_load(y1_ + 64 * j); H_[j] = __builtin_nontemporal_load(hr_ + 64 * j); } } while (0)
        P8_LOAD(c0, c1, ch, row_base + F.wave);
        __syncthreads();
        for (int i = F.tid; i < D; i += NWAVES * 64) A4[i] = modv(P, b, 5 * D + i) * P.g_ffn_post[i];
        __syncthreads();
        for (int rr = F.wave; rr < RPB; rr += NWAVES) {
            const int row = row_base + rr; YT n0[8], n1[8]; u32x2 nh[8];
            if (rr + NWAVES < RPB) P8_LOAD(n0, n1, nh, row + NWAVES);
            f32x4 v[8]; float ss = 0.f;
#pragma unroll
            for (int j = 0; j < 8; ++j) { f32x4 a, c;
                if constexpr (YK_FP8) { fp8x4_to_f(c0[j][0], a); fp8x4_to_f(c1[j][0], c); v[j] = (a + c) * (1.f / Y8_SCALE); }
                else { u32x2 t0, t1; t0.x = c0[j][0]; t0.y = c0[j][YK_FP8 ? 0 : 1]; t1.x = c1[j][0]; t1.y = c1[j][YK_FP8 ? 0 : 1]; bf4_to_f(t0, a); bf4_to_f(t1, c); v[j] = a + c; }
                ss += (v[j].x * v[j].x + v[j].y * v[j].y) + (v[j].z * v[j].z + v[j].w * v[j].w); }
            const float r = rsqrtf(wave_sum(ss) * (1.f / D) + EPS);
            GAS f32x4* ho = (GAS f32x4*)(P.out + (size_t)row * D) + lane;
#pragma unroll
            for (int j = 0; j < 8; ++j) { const f32x4 a4 = *(const LAS f32x4*)(A4 + 4 * lane + 256 * j); { f32x4 hv; bf4_to_f(ch[j], hv); __builtin_nontemporal_store(hv + a4 * (v[j] * r), ho + 64 * j); } }
#pragma unroll
            for (int j = 0; j < 8; ++j) { c0[j] = n0[j]; c1[j] = n1[j]; ch[j] = nh[j]; }
        }
#undef P8_LOAD
    }
}

struct Args { const void* in[23]; float* out; unsigned char* ws; int ph_lo, ph_hi; };
__global__ void __launch_bounds__(NWAVES * 64, 2) mega_fwd(Args args) {
    extern __shared__ __attribute__((aligned(16))) unsigned char lds[];
    Frame F;
    F.lds = (LAS unsigned char*)lds; F.MISC = (volatile LAS unsigned*)(F.lds + MISC_OFF);
    F.tid = threadIdx.x; F.lane = F.tid & 63; F.wave = __builtin_amdgcn_readfirstlane(F.tid >> 6); F.G = gridDim.x; F.gw = blockIdx.x * NWAVES + F.wave; F.NGW = F.G * NWAVES;
    unsigned char* ws = args.ws; F.ctl = (gu32*)(ws + WS_CTL);
#define PTRS(P) Ptrs P; { P.x = (const float*)args.in[0]; P.c = (const float*)args.in[1]; P.pos = (const int*)args.in[2]; P.w_ada = (const float*)args.in[3]; P.b_ada = (const float*)args.in[4]; P.g_mix_pre = (const float*)args.in[5]; \
    P.g_mix_post = (const float*)args.in[6]; P.w_in = (const float*)args.in[7]; P.sink = (const float*)args.in[8]; P.gn = (const float*)args.in[9]; P.wsp = (const float*)args.in[10]; P.bsp = (const float*)args.in[11]; \
    P.gg = (const float*)args.in[12]; P.w_out = (const float*)args.in[13]; P.g_ffn_pre = (const float*)args.in[14]; P.g_ffn_post = (const float*)args.in[15]; P.w_rg = (const float*)args.in[16]; P.b_rg = (const float*)args.in[17]; \
    P.w_re = (const float*)args.in[18]; P.b_re = (const float*)args.in[19]; P.w_gate = (const float*)args.in[20]; P.w_up = (const float*)args.in[21]; P.w_down = (const float*)args.in[22]; P.out = args.out; \
    P.mod = (float*)(ws + WS_MOD); P.rope = (float*)(ws + WS_ROPE); P.ssp = (float*)(ws + WS_SSP); P.list = (unsigned*)(ws + WS_LIST); P.lw = (float*)(ws + WS_LW); P.wrgT = (float*)(ws + WS_WRG); P.wreT = (float*)(ws + WS_WRE); \
    P.wsb = (bf16*)(ws + WS_WSB); P.WinT = (bf16*)(ws + WS_WIN); P.WoT = (bf16*)(ws + WS_WO); P.WguT = (bf16*)(ws + WS_WGU); P.WdT = (bf16*)(ws + WS_WD); P.A = (bf16*)(ws + WS_A); P.Z = (bf16*)(ws + WS_Z); P.Y = (bf16*)(ws + WS_Y); \
    P.MIX = (bf16*)(ws + WS_MIX); P.HB = (bf16*)(ws + WS_HB); P.ctlcnt = (unsigned*)(ws + WS_CTL) + CW_CNT; P.wmaxw = (unsigned*)(ws + WS_CTL) + CW_WMAX; P.asc = (float*)(ws + WS_ASC); P.HID = (bf16*)(ws + WS_HID); P.YK = (bf16*)(ws + WS_YK); }
    for (int u = F.tid; u < (LDS_BYTES - MISC_OFF) / 4; u += NWAVES * 64) ((LAS unsigned*)(F.lds + MISC_OFF))[u] = 0u;
    __syncthreads();
    const int lo = args.ph_lo, hi = args.ph_hi;
    XcdBarrier bar; bar.bar = (unsigned*)(F.ctl + CW_BAR); bar.x = 0; bar.st = nullptr;
    if (hi - lo > 1) bar = xcd_barrier_post((unsigned*)(F.ctl + CW_BAR), F.MISC + 24);
#define IN(k) (lo <= (k) && (k) < hi)
#define SEAM(k) do { if (IN(k) && IN((k) + 1)) xcd_barrier(bar); } while (0)
    LAS unsigned* tab = (LAS unsigned*)(F.lds + TAB_OFF); LAS int* tp = (LAS int*)(F.lds + MISC_OFF);

    if (IN(0)) { PTRS(P); p0_prologue(F, P); } SEAM(0);
    if (IN(1)) { PTRS(P); p1_norm(F, P); } SEAM(1);
    if (IN(2)) { PTRS(P); const int ncv = conv_wgs(F.G), gg2 = F.G - ncv;
        if ((int)blockIdx.x < gg2) { pg8::DenseOrder S2; S2.init(P.A, P.WinT, T, INW, INP_I8 ? D / 2 : D, gg2, (int)blockIdx.x);
            LAS f32x2* rt2 = (LAS f32x2*)tab; const float wq = INP_I8 ? __uint_as_float(__hip_atomic_load(P.wmaxw, RLX_AGENT)) * (1.f / 127.f) : 1.f;
            for (int idx = F.tid; idx < 4 * 256; idx += NWAVES * 64) { pg8::Unit u; if (S2.next(idx >> 8, u)) { const int row = u.pm * 256 + (idx & 255); rt2[idx] = (f32x2){INP_I8 ? P.asc[row] * wq : 1.f, (float)P.pos[row]}; } }
            __syncthreads();
            pg8::EpiInproj E{P.Z, rt2};
            pg8::gemm_core<pg8::EpiInproj, pg8::DenseOrder, false, false, INP_I8 ? 2 : 0>(F.lds, S2, E, nullptr); }
        else { LAS float* scr = (LAS float*)(F.lds + F.wave * 16384); convert_range(P, P0_SPLIT + ((int)blockIdx.x - gg2) * NWAVES + F.wave, I_DOWN0, ncv * NWAVES, scr, F.lane); } } SEAM(2);
    if (IN(3)) { PTRS(P); p3_mixer(F, P); } SEAM(3);
    if (IN(4)) { PTRS(P); pg8::DenseOrder S4; S4.init(P.Y, P.WoT, T, D, OUT_F8 ? D / 2 : D, F.G, (int)blockIdx.x);
        LAS f32x2* rr = (LAS f32x2*)tab; LAS unsigned* gt4 = tab + 4 * 512; pg8::Unit u; S4.gather = OUT_F8 != 0;
        for (int i = 0; i < 4 && S4.next(i, u); ++i) { f32x4 v[4];
#pragma unroll
            for (int j = 0; j < 4; ++j) { const int idx = F.tid + NWAVES * 64 * j; v[j] = ((idx & 7) < 6) ? *(const f32x4*)(P.ssp + (size_t)(u.pm * 256 + (idx >> 3)) * SSPW + 4 * (idx & 7)) : (f32x4){0.f, 0.f, 0.f, 0.f}; }
#pragma unroll
            for (int j = 0; j < 4; ++j) { const int idx = F.tid + NWAVES * 64 * j, r = idx >> 3, q = idx & 7; const float s = (v[j].x + v[j].y) + (v[j].z + v[j].w); float sa = q < 2 ? s : 0.f, sg = q < 2 ? 0.f : s;
                sa += __shfl_xor(sa, 1); sg += __shfl_xor(sg, 1); sg += __shfl_xor(sg, 2); sg += __shfl_xor(sg, 4);
                if (q == 0) { const float ra = rsqrtf(sa * (1.f / AW) + EPS), rg = rsqrtf(sg * (1.f / AW) + EPS); rr[i * 256 + r] = (f32x2){ra / rg, rg}; gt4[i * 256 + r] = (unsigned)(u.pm * 256 + r) * (unsigned)D; } } }
        __syncthreads();
        pg8::EpiOutproj E{P.MIX, rr};
        if constexpr (OUT_F8) pg8::gemm_core<pg8::EpiOutproj, pg8::DenseOrder, true, true, 1>(F.lds, S4, E, gt4);
        else pg8::gemm_core<pg8::EpiOutproj, pg8::DenseOrder, false, true, 0>(F.lds, S4, E, nullptr); } SEAM(4);
    if (IN(5)) { PTRS(P); p5_thin(F, P); } SEAM(5);
    if (IN(6) || IN(7)) {
        if (F.tid == 0) { int o = 0; for (int e = 0; e < NE; ++e) { tp[e] = o; o += (int)((__hip_atomic_load(F.ctl + CW_CNT + e, RLX_AGENT) + 255u) >> 8); } tp[NE] = o; }
        __syncthreads();
    }
    if (IN(6)) { PTRS(P); pg8::MoeOrder S6{(const char*)P.A, (const char*)P.WguT, MOE_FP8 ? D / 2 : D, FF / 128, (size_t)2048 * 2048 * (MOE_FP8 ? 1 : 2), tp, F.G, (int)blockIdx.x, true};
        LAS unsigned* gt = tab; LAS float* wt = (LAS float*)(tab + MAX_SLOTS * 256); pg8::Unit u;
#pragma unroll
        for (int j = 0; j < 4; ++j) { const int idx = F.tid + NWAVES * 64 * j, i = idx >> 8, r = idx & 255;
            if (i < MAX_SLOTS && S6.next(i, u)) { const unsigned n = __hip_atomic_load(F.ctl + CW_CNT + u.e, RLX_AGENT); const unsigned m = (unsigned)u.pm * 256u + r;
                const bool ok = m < n; gt[i * 256 + r] = ok ? (P.list[u.e * T + m] >> 1) * (unsigned)(MOE_FP8 ? D : D * 2) : 0u; wt[i * 256 + r] = ok ? P.lw[u.e * T + m] : 0.f; } }
        __syncthreads();
        pg8::EpiGateUp E{(unsigned char*)P.HID, wt, tp}; pg8::gemm_core<pg8::EpiGateUp, pg8::MoeOrder, true, false, MOE_FP8 ? 1 : 0>(F.lds, S6, E, gt);
        if (conv_wgs(F.G)) {
            LAS float* scr = (LAS float*)(F.lds + F.wave * 16384); const int nmax = S6.max_units();
            int nidle = 0, myidx = -1;
            if (S6.xcd()) { const int W = F.G >> 3, mx = (int)blockIdx.x & 7, mr = (int)blockIdx.x >> 3;
                for (int x = 0; x < 8; ++x) { const int U = S6.group_units(x), q = (U + W - 1) / W; const int first = (q < nmax) ? 0 : U - (nmax - 1) * W;
                    if (x == mx && mr >= first) myidx = nidle + (mr - first); nidle += W - first; } }
            else { const int rem = (tp[NE] * (FF / 128)) % F.G; if (rem != 0) { nidle = F.G - rem; if ((int)blockIdx.x >= rem) myidx = (int)blockIdx.x - rem; } }
            if (nidle < 96) convert_range(P, I_DOWN0 + F.gw, NITEMS, F.NGW, scr, F.lane);
            else if (myidx >= 0) convert_range(P, I_DOWN0 + myidx * NWAVES + F.wave, NITEMS, nidle * NWAVES, scr, F.lane);
        } } SEAM(6);
    if (IN(7)) { PTRS(P); pg8::MoeOrder S7{(const char*)P.HID, (const char*)P.WdT, MOE_FP8 ? FF / 2 : FF, D / 256, (size_t)2048 * 1024 * (MOE_FP8 ? 1 : 2), tp, F.G, (int)blockIdx.x, true};
        LAS unsigned* dt = tab; LAS unsigned* gt7 = tab + MAX_SLOTS * 256; pg8::Unit u;
#pragma unroll
        for (int j = 0; j < 4; ++j) { const int idx = F.tid + NWAVES * 64 * j, i = idx >> 8, r = idx & 255;
            if (i < MAX_SLOTS && S7.next(i, u)) { const unsigned n = __hip_atomic_load(F.ctl + CW_CNT + u.e, RLX_AGENT); const unsigned m = (unsigned)u.pm * 256u + r;
                dt[i * 256 + r] = m < n ? P.list[u.e * T + m] : 0xffffffffu; gt7[i * 256 + r] = (unsigned)((tp[u.e] + u.pm) * 256 + r) * (unsigned)(MOE_FP8 ? FF : FF * 2); } }
        __syncthreads();
        pg8::EpiDown E{(unsigned char*)P.YK, dt}; pg8::gemm_core<pg8::EpiDown, pg8::MoeOrder, true, false, MOE_FP8 ? 1 : 0>(F.lds, S7, E, gt7); } SEAM(7);
    if (IN(8)) { PTRS(P); p8_final(F, P);
        if (__hip_atomic_load(F.ctl + CW_BAR + XB_TMO, RLX_AGENT) != 0u) { const float q = __builtin_nanf(""); for (int row = F.gw; row < T; row += F.NGW) for (int j = F.lane; j < D; j += 64) P.out[(size_t)row * D + j] = q; } }
#undef IN
#undef SEAM
}

extern "C" void kernel_launch(void* const* d_in, const int* in_sizes, int n_in, void* d_out, int out_size, void* d_ws, size_t ws_size, hipStream_t stream) {
    static int grid = 0;
    if (grid == 0) {
        if (n_in != 23 || in_sizes[0] != T * D || out_size != T * D || ws_size < WS_END) { fprintf(stderr, "kernel_launch: unexpected shapes / workspace (%d inputs, ws %zu)\n", n_in, ws_size); grid = -1; return; }
        int dev = 0, cus = 0, per_cu = 0;
        if (hipGetDevice(&dev) != hipSuccess || hipDeviceGetAttribute(&cus, hipDeviceAttributeMultiprocessorCount, dev) != hipSuccess) { grid = -1; return; }
        if (hipFuncSetAttribute((const void*)mega_fwd, hipFuncAttributeMaxDynamicSharedMemorySize, LDS_BYTES) != hipSuccess) { grid = -1; return; }
        if (hipOccupancyMaxActiveBlocksPerMultiprocessor(&per_cu, (const void*)mega_fwd, NWAVES * 64, LDS_BYTES) != hipSuccess || per_cu < 1) fprintf(stderr, "kernel_launch: occupancy query says %d\n", per_cu);
        (void)hipGetLastError();
        grid = cus;
        if (grid != 256) fprintf(stderr, "kernel_launch: %d CUs (built for 256)\n", grid);
    }
    if (grid < 0) return;
    (void)hipMemsetAsync((char*)d_ws + WS_CTL, 0, CTL_ZERO_BYTES, stream);
    Args a; memset(&a, 0, sizeof(a));
    for (int i = 0; i < 23; ++i) a.in[i] = d_in[i];
    a.out = (float*)d_out; a.ws = (unsigned char*)d_ws; a.ph_lo = 0; a.ph_hi = 9;
    hipLaunchKernelGGL(mega_fwd, dim3(grid), dim3(NWAVES * 64), LDS_BYTES, stream, a);
}
```

```cpp
#include <hip/hip_runtime.h>
#include <cstdio>
#include <cstdint>
#include <cstring>

#ifndef MOE_FP8
#define MOE_FP8 1
#endif

constexpr int D = 2048, NB = 8, S = 2048, T = NB * S, HD = 128, AW = 1024, AH = 8, KVH = 2, GH = 8, INW = 3584;
constexpr int WIN = 128, CH = 128, NG = 4, EPG = 4, NE = 16, FF = 1024, NMOD = 6, MODW = NMOD * D;
constexpr int OQ = 0, OK_ = 1024, OV = 1280, OU = 1536, OVG = 2560;
constexpr float EPS = 1e-6f;
constexpr float LOG2E = 1.4426950408889634f;
constexpr float C2 = 0.08838834764831845f * LOG2E;
constexpr int HID_ROWS = 2 * T + NE * 256;
constexpr int SSPW = 32;

typedef unsigned short bf16;
typedef short bf16x8 __attribute__((ext_vector_type(8)));
typedef short s16x4 __attribute__((ext_vector_type(4)));
typedef short v4i16_t __attribute__((ext_vector_type(4)));
typedef float f32x2 __attribute__((ext_vector_type(2)));
typedef float f32x4 __attribute__((ext_vector_type(4)));
typedef float f32x16 __attribute__((ext_vector_type(16)));
typedef unsigned u32x2 __attribute__((ext_vector_type(2)));
typedef unsigned u32x4 __attribute__((ext_vector_type(4)));
#define DI __device__ __forceinline__
#define GAS __attribute__((address_space(1)))
#define LAS __attribute__((address_space(3)))
typedef GAS unsigned gu32;

constexpr size_t MiB = 1u << 20;
constexpr size_t WS_CTL = 0, CTL_ZERO_BYTES = 65536;
constexpr size_t WS_MOD = 1 * MiB;
constexpr size_t WS_ROPE = 3 * MiB;
constexpr size_t WS_SSP = 5 * MiB;
constexpr size_t WS_LIST = 7 * MiB;
constexpr size_t WS_LW = 8 * MiB;
constexpr size_t WS_WRG = 9 * MiB;
constexpr size_t WS_WRE = 9 * MiB + 65536;
constexpr size_t WS_WSB = 9 * MiB + 262144;
constexpr size_t WS_ASC = 9 * MiB + 786432;
constexpr size_t WS_WIN = 10 * MiB;
constexpr size_t WS_WO = 24 * MiB;
constexpr size_t WS_WGU = 32 * MiB;
constexpr size_t WS_WD = 160 * MiB;
constexpr size_t WS_A = 224 * MiB;
constexpr size_t WS_Z = 288 * MiB;
constexpr size_t WS_Y = 400 * MiB;
constexpr size_t WS_HB = 400 * MiB;
constexpr size_t WS_MIX = 464 * MiB;
constexpr size_t WS_HID = 288 * MiB;
constexpr size_t WS_YK = 464 * MiB;
constexpr size_t WS_END = 592 * MiB;
constexpr int CW_TMO = 0, CW_CNT = 64, CW_WMAX = 96, CW_BAR = 4096;

DI float bf2f(bf16 h) { return __uint_as_float(((unsigned)h) << 16); }
DI bf16 f2bf(float f) { unsigned u = __float_as_uint(f); return (bf16)((u + 0x7fffu + ((u >> 16) & 1u)) >> 16); }
DI unsigned cvt_pk_bf16(float lo, float hi) { unsigned r; asm volatile("v_cvt_pk_bf16_f32 %0, %1, %2" : "=v"(r) : "v"(lo), "v"(hi)); return r; }
typedef float f32x2_t __attribute__((ext_vector_type(2))); typedef __bf16 bf16x2_t __attribute__((ext_vector_type(2)));
DI unsigned cvtpk_s(float lo, float hi) { f32x2_t v = {lo, hi}; bf16x2_t b = __builtin_convertvector(v, bf16x2_t); return __builtin_bit_cast(unsigned, b); }
DI unsigned pack4_i8(float a, float b, float c, float d) { const int q0 = (int)rintf(a), q1 = (int)rintf(b), q2 = (int)rintf(c), q3 = (int)rintf(d); return (unsigned)(q0 & 255) | ((unsigned)(q1 & 255) << 8) | ((unsigned)(q2 & 255) << 16) | ((unsigned)q3 << 24); }
DI float clamp127(float v) { return __builtin_amdgcn_fmed3f(v, -127.f, 127.f); }
DI u32x4 pair16(u32x2 a, u32x2 b) { const auto r0 = __builtin_amdgcn_permlane16_swap(a.x, b.x, false, false); const auto r1 = __builtin_amdgcn_permlane16_swap(a.y, b.y, false, false); return (u32x4){r0[0], r1[0], r0[1], r1[1]}; }
constexpr float W8_SCALE = 32.f, H8_SCALE = 16.f, Y8_SCALE = 64.f, YA_SCALE = 4.f;
DI float clamp8(float v) { return __builtin_amdgcn_fmed3f(v, -448.f, 448.f); }
DI unsigned pack4_fp8(float a, float b, float c, float d) { int p = 0; p = __builtin_amdgcn_cvt_pk_fp8_f32(clamp8(a), clamp8(b), p, false); p = __builtin_amdgcn_cvt_pk_fp8_f32(clamp8(c), clamp8(d), p, true); return (unsigned)p; }
typedef int v4i32 __attribute__((ext_vector_type(4))); typedef int v8i32 __attribute__((ext_vector_type(8)));
DI v8i32 cat8(bf16x8 lo, bf16x8 hi) { const v4i32 a = __builtin_bit_cast(v4i32, lo), b = __builtin_bit_cast(v4i32, hi); return __builtin_shufflevector(a, b, 0, 1, 2, 3, 4, 5, 6, 7); }
#define DPP_ADD(v, ctrl) (v) += __builtin_bit_cast(float, __builtin_amdgcn_update_dpp(0, __builtin_bit_cast(int, (v)), (ctrl), 0xF, 0xF, true))
DI float wave_sum(float v) {
    DPP_ADD(v, 0x111); DPP_ADD(v, 0x112); DPP_ADD(v, 0x114); DPP_ADD(v, 0x118);
    const int b = __builtin_bit_cast(int, v);
    return (__builtin_bit_cast(float, __builtin_amdgcn_readlane(b, 15)) + __builtin_bit_cast(float, __builtin_amdgcn_readlane(b, 31))) + (__builtin_bit_cast(float, __builtin_amdgcn_readlane(b, 47)) + __builtin_bit_cast(float, __builtin_amdgcn_readlane(b, 63)));
}
DI float sum16(float v) {
    DPP_ADD(v, 0xB1); DPP_ADD(v, 0x4E); DPP_ADD(v, 0x141); DPP_ADD(v, 0x140); return v;
}
DI float xsum32(float v) { const auto rr = __builtin_amdgcn_permlane32_swap(__float_as_uint(v), __float_as_uint(v), false, false); return __uint_as_float(rr[0]) + __uint_as_float(rr[1]); }
DI float xmax32(float v) { const auto rr = __builtin_amdgcn_permlane32_swap(__float_as_uint(v), __float_as_uint(v), false, false); return fmaxf(__uint_as_float(rr[0]), __uint_as_float(rr[1])); }
DI float xother32(float v) { const unsigned b = __float_as_uint(v); const auto rr = __builtin_amdgcn_permlane32_swap(b, b, false, false); return __uint_as_float(rr[0] ^ rr[1] ^ b); }
DI f32x2 gelu_pk(f32x2 v) {
    const f32x2 av = __builtin_elementwise_abs(v), d = av * 0.2316418882f + 1.0f;
    f32x2 t; t.x = __builtin_amdgcn_rcpf(d.x); t.y = __builtin_amdgcn_rcpf(d.y);
    f32x2 q = t * 0.5307027145f + (-0.7265760135f); q = q * t + 0.7107068705f; q = q * t + (-0.142248368f); q = q * t + 0.127414796f; q = q * t;
    const f32x2 s = (v * v) * (-0.72134752044f);
    f32x2 e; e.x = __builtin_amdgcn_exp2f(s.x); e.y = __builtin_amdgcn_exp2f(s.y);
    const f32x2 m = v * (q * e), r = v - m;
    f32x2 o; o.x = v.x < 0.f ? m.x : r.x; o.y = v.y < 0.f ? m.y : r.y; return o;
}
#define LDS_WAIT() asm volatile("s_waitcnt lgkmcnt(0)" ::: "memory")
#define VM_WAIT() asm volatile("s_waitcnt vmcnt(0)" ::: "memory")
#define RLX_AGENT __ATOMIC_RELAXED, __HIP_MEMORY_SCOPE_AGENT

namespace pg8 {
constexpr int BM = 256, BK = 64, HALF = 128, HTB = HALF * BK * 2, NXCD = 8, WGM = 8;
__host__ __device__ __forceinline__ int lds_byte(int r, int c) { const int st = (r >> 4) * 2 + (c >> 5), rr = r & 15, cc = c & 31, ob = rr * 64 + cc * 2; return st * 1024 + (ob ^ (((ob >> 9) & 1) << 5)); }
__host__ __device__ __forceinline__ void stage_rc(int b, int& R, int& C) { const int st = b / 1024, sb = b % 1024, swz = sb ^ (((sb >> 9) & 1) << 5); R = (st >> 1) * 16 + swz / 64; C = (st & 1) * 32 + (swz % 64) / 2; }
__host__ __device__ __forceinline__ int perm32(int rho) { const int n = rho >> 4, i = rho & 15; return 8 * (i >> 2) + 4 * n + (i & 3); }

struct Unit { int pm, pn, e, slot; };

struct DenseOrder {
    const char* A; const char* Bt; int K; int nM, nN, nwg, G, c;
    DI void init(const void* A_, const void* Bt_, int M, int N, int K_, int G_, int c_) { A = (const char*)A_; Bt = (const char*)Bt_; K = K_; nM = M / BM; nN = N / BM; nwg = nM * nN; G = G_; c = c_; }
    DI bool next(int i, Unit& u) const {
        const long L = (long)i * G + c; if (L >= nwg) return false;
        int wgid = (int)L; { const int q = nwg / NXCD, r = nwg % NXCD, xcd = wgid % NXCD, off = wgid / NXCD; wgid = (xcd < r ? xcd * (q + 1) : r * (q + 1) + (xcd - r) * q) + off; }
        const int nig = WGM * nN, gid = wgid / nig, fm = gid * WGM, gsz = (nM - fm) < WGM ? (nM - fm) : WGM;
        u.pm = fm + ((wgid % nig) % gsz); u.pn = (wgid % nig) / gsz; u.e = 0; u.slot = i; return true;
    }
    bool gather = false;
    DI const char* a_base(const Unit& u) const { return gather ? A : A + (size_t)u.pm * BM * K * 2; }
    DI const char* b_base(const Unit& u) const { return Bt + (size_t)u.pn * BM * K * 2; }
};
#ifndef INP_I8
#define INP_I8 1
#endif
#ifndef OUT_F8
#define OUT_F8 1
#endif
#ifndef YK_FP8
#define YK_FP8 1
#endif
#ifndef MOE_XCD
#define MOE_XCD 0
#endif
struct MoeOrder {
    const char* A; const char* Bt; int K, nN; size_t bstride  ; LAS const int* tp; int G, c; bool gather;
    DI bool xcd() const { return MOE_XCD && (G % 8 == 0); }
    DI int group_units(int x) const { return ((tp[x + 1] - tp[x]) + (tp[x + 9] - tp[x + 8])) * nN; }
    DI int my_units() const {
        if (xcd()) { const int W = G >> 3, r = c >> 3, U = group_units(c & 7); return U > r ? (U - r + W - 1) / W : 0; }
        const int tot = tp[NE] * nN; return tot > c ? (tot - c + G - 1) / G : 0;
    }
    DI int max_units() const {
        if (xcd()) { const int W = G >> 3; int m = 0;
#pragma unroll
            for (int x = 0; x < 8; ++x) { const int q = (group_units(x) + W - 1) / W; m = q > m ? q : m; } return m; }
        return (tp[NE] * nN + G - 1) / G;
    }
    DI bool next(int i, Unit& u) const {
        if (xcd()) {
            const int x = c & 7, r = c >> 3, W = G >> 3; const int t0 = tp[x + 1] - tp[x], t1 = tp[x + 9] - tp[x + 8];
            int k = r + W * i; if (k >= (t0 + t1) * nN) return false;
            int e = x; if (k >= t0 * nN) { e = x + 8; k -= t0 * nN; }
            u.e = e; u.pm = k / nN; u.pn = k % nN; u.slot = i; return true;
        }
        const int L = i * G + c; const int tot = tp[NE] * nN; if (L >= tot) return false;
        const int mt = L / nN; u.pn = L % nN; int e = 0;
#pragma unroll
        for (int k = 1; k < NE; ++k) e += (mt >= tp[k]) ? 1 : 0;
        u.e = e; u.pm = mt - tp[e]; u.slot = i; return true;
    }
    DI const char* a_base(const Unit& u) const { return gather ? A : A + (size_t)(tp[u.e] + u.pm) * BM * K * 2; }
    DI const char* b_base(const Unit& u) const { return Bt + (size_t)u.e * bstride + (size_t)u.pn * BM * K * 2; }
};

template <class Epi, class Sched, bool GATHER, bool MIDK, int QM = 0>
DI void gemm_core(LAS unsigned char* lds, const Sched& S, const Epi& E, LAS const unsigned* gtab) {
    const int tid = threadIdx.x, wid = __builtin_amdgcn_readfirstlane(tid >> 6), lane = tid & 63, wr = wid >> 2, wc = wid & 3, fr = lane & 15, fq = lane >> 4;
    const int K = S.K, nt = K / BK;
    unsigned voffA[2], voffB[2]; int RA[2];
#pragma unroll
    for (int i = 0; i < 2; ++i) { int R, C; stage_rc(tid * 16 + i * 8192, R, C); const int Rb = Epi::PERM ? (64 * (R >> 5) + perm32(R & 31)) : R;
        RA[i] = R; voffA[i] = GATHER ? (unsigned)(C * 2) : (unsigned)(R * K + C) * 2u; voffB[i] = (unsigned)(Rb * K + C) * 2u; }
    const size_t kstep = (size_t)(BK * 2);
    const size_t hstep = (size_t)HALF * K * 2;
    const size_t bhstep = Epi::PERM ? (size_t)32 * K * 2 : hstep;
    const unsigned ldsw = (unsigned)wid * 1024u;
    const int aoff = lds_byte(wr * 64 + fr, fq * 8), boff = lds_byte(wc * 32 + fr, fq * 8);
#define PG8_SA(b, h) (((b) * 2 + (h)) * HTB)
#define PG8_SB(b, h) ((4 + (b) * 2 + (h)) * HTB)
#define PG8_STAGE(bufoff, gbase, voff) do { _Pragma("unroll") for (int _i = 0; _i < 2; ++_i) \
        __builtin_amdgcn_global_load_lds((const unsigned*)((const char*)(gbase) + (voff)[_i]), (LAS unsigned*)(lds + (bufoff) + ldsw + _i * 8192), 16, 0, 0); } while (0)
#define PG8_STAGE_A(bufoff, kb, h, VA) do { if constexpr (GATHER) { PG8_STAGE(bufoff, kb, VA[h]); } else { PG8_STAGE(bufoff, (kb) + (h) * hstep, voffA); } } while (0)
#define PG8_LDA(dst, b, h) do { _Pragma("unroll") for (int m = 0; m < 4; ++m) _Pragma("unroll") for (int k = 0; k < 2; ++k) dst[m][k] = *(const LAS bf16x8*)(lds + PG8_SA(b, h) + aoff + m * 2048 + k * 1024); } while (0)
#define PG8_LDB(dst, b, h) do { _Pragma("unroll") for (int n = 0; n < 2; ++n) _Pragma("unroll") for (int k = 0; k < 2; ++k) dst[n][k] = *(const LAS bf16x8*)(lds + PG8_SB(b, h) + boff + n * 2048 + k * 1024); } while (0)
#define PG8_MMA(ai, bj, At, Bt) do { __builtin_amdgcn_s_setprio(1); _Pragma("unroll") for (int m = 0; m < 4; ++m) _Pragma("unroll") for (int n = 0; n < 2; ++n) { \
        if constexpr (QM == 1) acc[ai][bj][m][n] = __builtin_amdgcn_mfma_scale_f32_16x16x128_f8f6f4(cat8(Bt[n][0], Bt[n][1]), cat8(At[m][0], At[m][1]), acc[ai][bj][m][n], 0, 0, 0, 0x7f7f7f7f, 0, 0x7f7f7f7f); \
        else if constexpr (QM == 2) { _Pragma("unroll") for (int k = 0; k < 2; ++k) acc[ai][bj][m][n] = __builtin_bit_cast(f32x4, __builtin_amdgcn_mfma_i32_16x16x64_i8(__builtin_bit_cast(v4i32, Bt[n][k]), __builtin_bit_cast(v4i32, At[m][k]), __builtin_bit_cast(v4i32, acc[ai][bj][m][n]), 0, 0, 0)); } \
        else { _Pragma("unroll") for (int k = 0; k < 2; ++k) acc[ai][bj][m][n] = __builtin_amdgcn_mfma_f32_16x16x32_bf16(Bt[n][k], At[m][k], acc[ai][bj][m][n], 0, 0, 0); } } __builtin_amdgcn_s_setprio(0); } while (0)
#define PG8_WAIT_V(n) asm volatile("s_waitcnt vmcnt(" #n ")" ::: "memory")
#define PG8_WAIT_L(n) asm volatile("s_waitcnt lgkmcnt(" #n ")" ::: "memory")
#define PG8_BAR __builtin_amdgcn_s_barrier()
#define PG8_SCHED __builtin_amdgcn_sched_barrier(0)
    Unit cur, nxt; int ui = 0;
    if (!S.next(0, cur)) return;
    f32x4 acc[2][2][4][2];
#pragma unroll
    for (int a = 0; a < 2; ++a)
#pragma unroll
        for (int b = 0; b < 2; ++b)
#pragma unroll
            for (int m = 0; m < 4; ++m)
#pragma unroll
                for (int n = 0; n < 2; ++n) acc[a][b][m][n] = (f32x4){0.f, 0.f, 0.f, 0.f};
    bf16x8 At[4][2], B0[2][2], B1[2][2];
    unsigned va[2][2];
    if constexpr (GATHER) {
#pragma unroll
        for (int h = 0; h < 2; ++h)
#pragma unroll
            for (int i = 0; i < 2; ++i) va[h][i] = gtab[cur.slot * 256 + h * 128 + RA[i]] + voffA[i];
    }
    const char* cA = S.a_base(cur); const char* cB = S.b_base(cur);
    PG8_STAGE(PG8_SB(0, 0), cB, voffB); PG8_STAGE(PG8_SB(0, 1), cB + bhstep, voffB); PG8_STAGE_A(PG8_SA(0, 0), cA, 0, va); PG8_STAGE_A(PG8_SA(0, 1), cA, 1, va);
    if (wr == 1) PG8_BAR;
    PG8_WAIT_V(2); PG8_BAR;
    PG8_STAGE(PG8_SB(1, 0), cB + kstep, voffB); PG8_STAGE_A(PG8_SA(1, 0), cA + kstep, 0, va); PG8_STAGE(PG8_SB(1, 1), cB + bhstep + kstep, voffB);
    PG8_WAIT_V(6); PG8_BAR;
    for (;;) {
        const bool has_next = S.next(ui + 1, nxt);
        const char* nA = has_next ? S.a_base(nxt) : cA; const char* nB = has_next ? S.b_base(nxt) : cB;
#pragma clang loop unroll(disable)
        for (int t = 0; t < nt; t += 2) {
            const bool last = (t == nt - 2);
            const char* a1 = cA + (size_t)(t + 1) * kstep;
            const char* a2 = last ? nA : cA + (size_t)(t + 2) * kstep; const char* b2 = last ? nB : cB + (size_t)(t + 2) * kstep;
            const char* a3 = a2 + kstep; const char* b3 = b2 + kstep;
            if constexpr (MIDK) { if (t == nt / 2) E.midk(acc, cur, wr, fr); }
            PG8_LDB(B0, 0, 0); PG8_LDB(B1, 0, 1); PG8_SCHED; PG8_LDA(At, 0, 0); PG8_STAGE_A(PG8_SA(1, 1), a1, 1, va);
            if constexpr (GATHER) { if (last && has_next) {
#pragma unroll
                for (int h = 0; h < 2; ++h)
#pragma unroll
                    for (int i = 0; i < 2; ++i) va[h][i] = gtab[nxt.slot * 256 + h * 128 + RA[i]] + voffA[i]; } }
            PG8_WAIT_V(8); PG8_WAIT_L(0); PG8_BAR; PG8_MMA(0, 0, At, B0); PG8_MMA(0, 1, At, B1); PG8_BAR; PG8_SCHED;
            PG8_LDA(At, 0, 1); PG8_STAGE(PG8_SB(0, 0), b2, voffB); PG8_STAGE(PG8_SB(0, 1), b2 + bhstep, voffB); PG8_STAGE_A(PG8_SA(0, 0), a2, 0, va);
            PG8_WAIT_V(8); PG8_WAIT_L(0); PG8_BAR; PG8_MMA(1, 0, At, B0); PG8_MMA(1, 1, At, B1); PG8_BAR; PG8_SCHED;
            PG8_LDB(B0, 1, 0); PG8_LDB(B1, 1, 1); PG8_SCHED; PG8_LDA(At, 1, 0); PG8_STAGE_A(PG8_SA(0, 1), a2, 1, va);
            PG8_WAIT_V(8); PG8_WAIT_L(0); PG8_BAR; PG8_MMA(0, 0, At, B0); PG8_MMA(0, 1, At, B1); PG8_BAR; PG8_SCHED;
            PG8_LDA(At, 1, 1); PG8_STAGE(PG8_SB(1, 0), b3, voffB); PG8_STAGE(PG8_SB(1, 1), b3 + bhstep, voffB); PG8_STAGE_A(PG8_SA(1, 0), a3, 0, va);
            PG8_WAIT_V(8); PG8_WAIT_L(0); PG8_BAR; PG8_MMA(1, 0, At, B0); PG8_MMA(1, 1, At, B1); PG8_BAR; PG8_SCHED;
        }
        if (wr == 0) PG8_BAR;
        E(acc, cur, wr, wc, fr, fq);
        if (!has_next) break;
#pragma unroll
        for (int a = 0; a < 2; ++a)
#pragma unroll
            for (int b = 0; b < 2; ++b)
#pragma unroll
                for (int m = 0; m < 4; ++m)
#pragma unroll
                    for (int n = 0; n < 2; ++n) acc[a][b][m][n] = (f32x4){0.f, 0.f, 0.f, 0.f};
        cur = nxt; cA = nA; cB = nB; ++ui;
        if (wr == 1) PG8_BAR;
    }
    PG8_WAIT_V(0);
    PG8_BAR;
#undef PG8_SA
#undef PG8_SB
#undef PG8_STAGE
#undef PG8_STAGE_A
#undef PG8_LDA
#undef PG8_LDB
#undef PG8_MMA
#undef PG8_WAIT_V
#undef PG8_WAIT_L
#undef PG8_BAR
#undef PG8_SCHED
}

struct EpiInproj {
    static constexpr bool PERM = true;
    bf16* Z; LAS const f32x2* rt;
    DI void operator()(const f32x4 (&acc)[2][2][4][2], const Unit& u, int wr, int wc, int fr, int fq) const {
        const int row0 = u.pm * BM + wr * 64 + fr, col0 = u.pn * BM + wc * 64 + 8 * fq;
        const int kind = u.pn < 4 ? 0 : (u.pn == 4 ? 1 : (u.pn == 5 ? 2 : 3));
        const float sc = kind == 0 ? C2 : 1.f;
        const bool dorope = (kind <= 1) && ((wc & 1) == 0);
        float ch[8], cl[8]; const bool odd = (fq & 1) != 0;
        ch[0] = odd ? 2.250790858e-04f : 1.591549367e-01f; cl[0] = odd ? -6.755001072e-12f : 6.420638243e-09f;
        ch[1] = odd ? 9.911730740e-05f : 7.008652389e-02f; cl[1] = odd ? 1.969154007e-12f : -2.302696700e-09f;
        ch[2] = odd ? 4.364795313e-05f : 3.086376376e-02f; cl[2] = odd ? -3.416928741e-13f : -3.597993847e-10f;
        ch[3] = odd ? 1.922110096e-05f : 1.359137055e-02f; cl[3] = odd ? -2.712567042e-13f : 9.086624508e-11f;
        ch[4] = odd ? 8.464330676e-06f : 5.985185504e-03f; cl[4] = odd ? 1.318804142e-13f : 2.087540557e-10f;
        ch[5] = odd ? 3.727408512e-06f : 2.635675948e-03f; cl[5] = odd ? 9.029300745e-14f : -4.944578774e-11f;
        ch[6] = odd ? 1.641426252e-06f : 1.160663669e-03f; cl[6] = odd ? 1.098673646e-14f : -2.775752544e-11f;
        ch[7] = odd ? 7.228293271e-07f : 5.111175124e-04f; cl[7] = odd ? -2.017673985e-14f : -7.822671330e-12f;
#pragma unroll
        for (int ai = 0; ai < 2; ++ai)
#pragma unroll
            for (int m = 0; m < 4; ++m) { const int rl = ai * HALF + wr * 64 + m * 16 + fr; bf16* rowp = Z + (size_t)(u.pm * BM + rl) * INW + col0;
                const f32x2 te = rt[u.slot * 256 + rl]; const float dq = te.x;
                f32x4 cs[2], sn[2];
                if (dorope) { const float p = te.y;
#pragma unroll
                    for (int n = 0; n < 2; ++n)
#pragma unroll
                        for (int j = 0; j < 4; ++j) { const int k = 4 * n + j; const float r = p * ch[k], e = __builtin_fmaf(p, ch[k], -r), x = __builtin_amdgcn_fractf(r) + __builtin_fmaf(p, cl[k], e);
                            cs[n][j] = __builtin_amdgcn_cosf(x); sn[n][j] = __builtin_amdgcn_sinf(x); }
                }
#pragma unroll
                for (int bj = 0; bj < 2; ++bj) { f32x4 v[2] = {acc[ai][bj][m][0], acc[ai][bj][m][1]};
                    if constexpr (INP_I8) { _Pragma("unroll") for (int n = 0; n < 2; ++n) { const v4i32 iv = __builtin_bit_cast(v4i32, v[n]); v[n] = (f32x4){(float)iv[0], (float)iv[1], (float)iv[2], (float)iv[3]} * dq; } }
                    if (kind == 3) {
#pragma unroll
                        for (int n = 0; n < 2; ++n) { f32x2 a = gelu_pk((f32x2){v[n][0], v[n][1]}), b = gelu_pk((f32x2){v[n][2], v[n][3]}); v[n] = (f32x4){a.x, a.y, b.x, b.y}; }
                    } else if (dorope && bj == 0) {
#pragma unroll
                        for (int n = 0; n < 2; ++n)
#pragma unroll
                            for (int j = 0; j < 4; ++j) { const float mine = v[n][j], other = xother32(mine);
                                v[n][j] = (fq < 2) ? (mine * cs[n][j] - other * sn[n][j]) : (mine * cs[n][j] + other * sn[n][j]); }
                    }
                    v[0] = v[0] * sc; v[1] = v[1] * sc;
                    u32x4 w; w.x = cvt_pk_bf16(v[0][0], v[0][1]); w.y = cvt_pk_bf16(v[0][2], v[0][3]); w.z = cvt_pk_bf16(v[1][0], v[1][1]); w.w = cvt_pk_bf16(v[1][2], v[1][3]);
                    *(u32x4*)(rowp + bj * 32) = w; } }
    }
};
struct EpiOutproj {
    static constexpr bool PERM = true;
    bf16* MIX; LAS const f32x2* rr;
    DI void midk(f32x4 (&acc)[2][2][4][2], const Unit& u, int wr, int fr) const {
#pragma unroll
        for (int ai = 0; ai < 2; ++ai)
#pragma unroll
            for (int m = 0; m < 4; ++m) { const float s = rr[u.slot * 256 + ai * HALF + wr * 64 + m * 16 + fr].x;
#pragma unroll
                for (int bj = 0; bj < 2; ++bj)
#pragma unroll
                    for (int n = 0; n < 2; ++n) acc[ai][bj][m][n] = acc[ai][bj][m][n] * s; }
    }
    DI void operator()(const f32x4 (&acc)[2][2][4][2], const Unit& u, int wr, int wc, int fr, int fq) const {
        const int col0 = u.pn * BM + wc * 64 + 8 * fq;
#pragma unroll
        for (int ai = 0; ai < 2; ++ai)
#pragma unroll
            for (int m = 0; m < 4; ++m) { const int rl = ai * HALF + wr * 64 + m * 16 + fr; const float s = rr[u.slot * 256 + rl].y * (OUT_F8 ? 1.f / (W8_SCALE * YA_SCALE) : 1.f); bf16* rowp = MIX + (size_t)(u.pm * BM + rl) * D + col0;
#pragma unroll
                for (int bj = 0; bj < 2; ++bj) { const f32x4 v0 = acc[ai][bj][m][0] * s, v1 = acc[ai][bj][m][1] * s;
                    u32x4 w; w.x = cvt_pk_bf16(v0[0], v0[1]); w.y = cvt_pk_bf16(v0[2], v0[3]); w.z = cvt_pk_bf16(v1[0], v1[1]); w.w = cvt_pk_bf16(v1[2], v1[3]);
                    *(u32x4*)(rowp + bj * 32) = w; } }
    }
};
struct EpiGateUp {
    static constexpr bool PERM = true;
    unsigned char* HID; LAS const float* wtab; LAS const int* tp;
    DI void operator()(const f32x4 (&acc)[2][2][4][2], const Unit& u, int wr, int wc, int fr, int fq) const {
        const int col0 = u.pn * HALF + wc * 32 + 8 * fq; const size_t rt = (size_t)(tp[u.e] + u.pm) * BM;
        constexpr float in_sc = MOE_FP8 ? 1.f / W8_SCALE : 1.f, out_sc = MOE_FP8 ? H8_SCALE : 1.f;
#pragma unroll
        for (int ai = 0; ai < 2; ++ai)
#pragma unroll
            for (int mp = 0; mp < 2; ++mp) { u32x2 pk8[2]; u32x4 pk16[2];
#pragma unroll
                for (int q = 0; q < 2; ++q) { const int m = 2 * mp + q; const int rl = ai * HALF + wr * 64 + m * 16 + fr; const float w = wtab[u.slot * 256 + rl] * out_sc; f32x4 o[2];
#pragma unroll
                    for (int n = 0; n < 2; ++n)
#pragma unroll
                        for (int j = 0; j < 4; ++j) { const float g = acc[ai][0][m][n][j] * in_sc, up = acc[ai][1][m][n][j] * in_sc; o[n][j] = g * __builtin_amdgcn_rcpf(1.f + __builtin_amdgcn_exp2f(-g * LOG2E)) * up * w; }
                    if constexpr (MOE_FP8) { pk8[q].x = pack4_fp8(o[0][0], o[0][1], o[0][2], o[0][3]); pk8[q].y = pack4_fp8(o[1][0], o[1][1], o[1][2], o[1][3]); }
                    else { pk16[q].x = cvt_pk_bf16(o[0][0], o[0][1]); pk16[q].y = cvt_pk_bf16(o[0][2], o[0][3]); pk16[q].z = cvt_pk_bf16(o[1][0], o[1][1]); pk16[q].w = cvt_pk_bf16(o[1][2], o[1][3]); } }
                const int rl0 = ai * HALF + wr * 64 + (2 * mp) * 16 + fr;
                if constexpr (MOE_FP8) {
                    const u32x4 w16 = pair16(pk8[0], pk8[1]); const int odd = fq & 1;
                    *(u32x4*)(HID + (rt + rl0 + 16 * odd) * FF + col0 - 8 * odd) = w16; }
                else { *(u32x4*)((bf16*)HID + (rt + rl0) * FF + col0) = pk16[0]; *(u32x4*)((bf16*)HID + (rt + rl0 + 16) * FF + col0) = pk16[1]; } }
    }
};
struct EpiDown {
    static constexpr bool PERM = true;
    unsigned char* YK; LAS const unsigned* dtab;
    DI void operator()(const f32x4 (&acc)[2][2][4][2], const Unit& u, int wr, int wc, int fr, int fq) const {
        const int col0 = u.pn * BM + wc * 64 + 8 * fq; constexpr float sc = (MOE_FP8 ? 1.f / (W8_SCALE * H8_SCALE) : 1.f) * (YK_FP8 ? Y8_SCALE : 1.f);
#pragma unroll
        for (int ai = 0; ai < 2; ++ai)
#pragma unroll
            for (int m = 0; m < 4; ++m) { const int rl = ai * HALF + wr * 64 + m * 16 + fr; const unsigned dst = dtab[u.slot * 256 + rl];
                if constexpr (YK_FP8) { u32x2 w[2];
#pragma unroll
                    for (int bj = 0; bj < 2; ++bj) { const f32x4 v0 = acc[ai][bj][m][0] * sc, v1 = acc[ai][bj][m][1] * sc; w[bj].x = pack4_fp8(v0[0], v0[1], v0[2], v0[3]); w[bj].y = pack4_fp8(v1[0], v1[1], v1[2], v1[3]); }
                    const u32x4 w16 = pair16(w[0], w[1]); const int odd = fq & 1;
                    if (dst != 0xffffffffu) *(u32x4*)(YK + (size_t)dst * D + col0 - 8 * odd + 32 * odd) = w16;
                } else { if (dst != 0xffffffffu) {
#pragma unroll
                    for (int bj = 0; bj < 2; ++bj) { const f32x4 v0 = acc[ai][bj][m][0] * sc, v1 = acc[ai][bj][m][1] * sc;
                        u32x4 w; w.x = cvt_pk_bf16(v0[0], v0[1]); w.y = cvt_pk_bf16(v0[2], v0[3]); w.z = cvt_pk_bf16(v1[0], v1[1]); w.w = cvt_pk_bf16(v1[2], v1[3]);
                        *(u32x4*)((bf16*)YK + (size_t)dst * D + col0 + bj * 32) = w; } } } }
    }
};
}

#define XB_TMO      128
#define XB_XCNT(j)  (256  + 64 * (j))
#define XB_XSUB(j)  (1280 + 64 * (j))
#define XB_XGEN(j)  (2304 + 64 * (j))
#define XB_TOP      3328
#define XB_TOPGEN   3392
#define XCD_BAR_WORDS 3456
#define XB_SPIN_CAP (1u << 18)
DI unsigned xb_ld(unsigned* p)              { return __hip_atomic_load(p, __ATOMIC_RELAXED, __HIP_MEMORY_SCOPE_AGENT); }
DI unsigned xb_add(unsigned* p, unsigned v) { return __hip_atomic_fetch_add(p, v, __ATOMIC_RELAXED, __HIP_MEMORY_SCOPE_AGENT); }
DI unsigned xb_xcc_id() { return (unsigned)__builtin_amdgcn_s_getreg((3 << 11) | 20) & 0xFu; }
#define XB_SPIN(cond, bar) do { unsigned _sp = 0; while (cond) { __builtin_amdgcn_s_sleep(1); \
    if ((++_sp & 255u) == 0u) { if (xb_ld(&(bar)[XB_TMO])) break; if (_sp > XB_SPIN_CAP) { atomicAdd(&(bar)[XB_TMO], 1u); break; } } } } while (0)
struct XcdBarrier { unsigned* bar; unsigned x; volatile LAS unsigned* st; };
DI XcdBarrier xcd_barrier_post(unsigned* bar, volatile LAS unsigned* st) {
    XcdBarrier b; b.bar = bar; b.x = xb_xcc_id(); b.st = st;
    if (threadIdx.x == 0) (void)xb_add(&bar[XB_XCNT(b.x)], 1u);
    return b;
}
DI void xcd_barrier_complete(unsigned* bar, unsigned x, unsigned& nloc, unsigned& nx) {
    const unsigned G = gridDim.x * gridDim.y * gridDim.z;
    unsigned sum, cnt, mine, sp = 0u;
    for (;;) {
        sum = 0u; cnt = 0u; mine = 0u;
#pragma unroll
        for (unsigned j = 0; j < 16; ++j) { const unsigned c = xb_ld(&bar[XB_XCNT(j)]); sum += c; cnt += (c > 0u) ? 1u : 0u; mine = (j == x) ? c : mine; }
        if (sum == G) break;
        __builtin_amdgcn_s_sleep(1);
        if ((++sp & 255u) == 0u) { if (xb_ld(&bar[XB_TMO])) break; if (sp > XB_SPIN_CAP) { atomicAdd(&bar[XB_TMO], 1u); break; } }
    }
    nloc = mine > 0u ? mine : 1u; nx = cnt > 0u ? cnt : 1u;
}
DI void xcd_barrier(const XcdBarrier& b) {
    asm volatile("s_waitcnt vmcnt(0)" ::: "memory");
    __syncthreads();
    if (threadIdx.x == 0) {
        unsigned* bar = b.bar;
        __builtin_amdgcn_s_waitcnt(0);
        unsigned nloc = b.st[0], nx = b.st[1];
        if (nloc == 0u) { xcd_barrier_complete(bar, b.x, nloc, nx); b.st[0] = nloc; b.st[1] = nx; }
        const unsigned old = xb_add(&bar[XB_XSUB(b.x)], 1u);
        const unsigned gen = old / nloc;
        if (old + 1u == (gen + 1u) * nloc) {
            __builtin_amdgcn_fence(__ATOMIC_RELEASE, "agent");
            asm volatile("s_waitcnt vmcnt(0)" ::: "memory");
            const unsigned og = xb_add(&bar[XB_TOP], 1u);
            const unsigned tg = og / nx;
            if (og + 1u == (tg + 1u) * nx) xb_add(&bar[XB_TOPGEN], 1u);
            else XB_SPIN(xb_ld(&bar[XB_TOPGEN]) == tg, bar);
            __builtin_amdgcn_fence(__ATOMIC_ACQUIRE, "agent");
            xb_add(&bar[XB_XGEN(b.x)], 1u);
            asm volatile("s_waitcnt vmcnt(0)" ::: "memory");
        } else {
            XB_SPIN(xb_ld(&bar[XB_XGEN(b.x)]) == gen, bar);
            __builtin_amdgcn_fence(__ATOMIC_ACQUIRE, "agent");
            asm volatile("s_waitcnt vmcnt(0)" ::: "memory");
        }
    }
    __syncthreads();
}

constexpr int NWAVES = 8;
constexpr int RING_BYTES = 131072;
constexpr int TAB_OFF = RING_BYTES;
constexpr int TAB_BYTES = 14336;
constexpr int MISC_OFF = TAB_OFF + TAB_BYTES;
constexpr int LDS_BYTES = 147456;
static_assert(MISC_OFF + 256 <= LDS_BYTES, "LDS map");
constexpr int MAX_SLOTS = 7;

struct Frame { LAS unsigned char* lds; volatile LAS unsigned* MISC; gu32* ctl; int tid, lane, wave, G, gw, NGW; };
struct Ptrs {
    const float *x, *c, *w_ada, *b_ada, *g_mix_pre, *g_mix_post, *w_in, *sink, *gn, *wsp, *bsp, *gg, *w_out, *g_ffn_pre, *g_ffn_post, *w_rg, *b_rg, *w_re, *b_re, *w_gate, *w_up, *w_down;
    const int* pos; float* out;
    float *mod, *rope, *ssp, *lw, *wrgT, *wreT, *asc; unsigned* list; unsigned* ctlcnt; unsigned* wmaxw; bf16 *MIX, *HB, *wsb, *WinT, *WoT, *WguT, *WdT, *A, *Z, *Y, *HID, *YK;
};
constexpr int I_IN = 32 * 112, I_OUT = 32 * 64, I_E = 1024, NITEMS = I_IN + I_OUT + 3 * NE * I_E;
#ifndef CONV_ITEMS
#define CONV_ITEMS 12288
#endif
constexpr int I_DOWN0 = I_IN + I_OUT + 2 * NE * I_E;
constexpr int P0_SPLIT = I_DOWN0 - CONV_ITEMS;
DI int conv_wgs(int G) { return (G == 256) ? 32 : 0; }
DI int conv_split(int G) { return conv_wgs(G) ? P0_SPLIT : NITEMS; }
struct ItemDesc { const float* W; bf16* WT; const float* kscale; int K, N, k0, n0, out_row0, f8; float qs; };
DI ItemDesc decode_item(const Ptrs& P, int it) {
    ItemDesc d; int r = it; d.kscale = nullptr; d.f8 = 0; d.qs = 1.f;
    if (r < I_IN) { d.W = P.w_in; d.WT = P.WinT; d.K = D; d.N = INW; d.k0 = 64 * (r / 112); d.n0 = 32 * (r % 112); d.out_row0 = d.n0;
        if (INP_I8) { d.f8 = 2; d.qs = 127.f / fmaxf(__uint_as_float(__hip_atomic_load(P.wmaxw, RLX_AGENT)), 1e-30f); } return d; } r -= I_IN;
    if (r < I_OUT) { d.W = P.w_out; d.WT = P.WoT; d.K = D; d.N = D; d.k0 = 64 * (r / 64); d.n0 = 32 * (r % 64); d.out_row0 = d.n0; d.kscale = P.gg; if (OUT_F8) d.f8 = 1; return d; } r -= I_OUT;
    const int which = r / (NE * I_E); r -= which * NE * I_E; const int e = r / I_E; r -= e * I_E; d.f8 = MOE_FP8;
    if (which < 2) { d.W = (which ? P.w_up : P.w_gate) + (size_t)e * D * FF; d.WT = P.WguT + (size_t)e * 2048 * (MOE_FP8 ? 1024 : 2048); d.K = D; d.N = FF; d.k0 = 64 * (r / 32); d.n0 = 32 * (r % 32); d.out_row0 = (d.n0 >> 7) * 256 + ((d.n0 >> 5) & 3) * 64 + which * 32; }
    else { d.W = P.w_down + (size_t)e * FF * D; d.WT = P.WdT + (size_t)e * 2048 * (MOE_FP8 ? 512 : 1024); d.K = FF; d.N = D; d.k0 = 64 * (r / 64); d.n0 = 32 * (r % 64); d.out_row0 = d.n0; }
    return d;
}
DI void item_load(const ItemDesc& d, f32x4 (&v)[8], int lane) {
    const float* p = d.W + (size_t)(d.k0 + (lane >> 3)) * d.N + d.n0 + 4 * (lane & 7);
#pragma unroll
    for (int i = 0; i < 8; ++i) v[i] = __builtin_nontemporal_load((const GAS f32x4*)(p + (size_t)(8 * i) * d.N));
}
DI void item_finish(const ItemDesc& d, const f32x4 (&v)[8], LAS float* scr, int lane) {
    const int kr = lane >> 3, q = lane & 7;
#pragma unroll
    for (int i = 0; i < 8; ++i) { f32x4 x = v[i]; if (d.kscale) x = x * d.kscale[d.k0 + 8 * i + kr]; LAS float* w = scr + (8 * i + kr) * 33 + 4 * q; w[0] = x.x; w[1] = x.y; w[2] = x.z; w[3] = x.w; }
    LDS_WAIT(); asm volatile("" ::: "memory");
    const int c = lane & 7;
    if (d.f8 == 2) {
#pragma unroll
        for (int j = 0; j < 4; ++j) { const int n = (lane >> 3) + 8 * j; const LAS float* s = scr + (8 * c) * 33 + n; const float q = d.qs;
            u32x2 o; o.x = pack4_i8(clamp127(s[0 * 33] * q), clamp127(s[1 * 33] * q), clamp127(s[2 * 33] * q), clamp127(s[3 * 33] * q)); o.y = pack4_i8(clamp127(s[4 * 33] * q), clamp127(s[5 * 33] * q), clamp127(s[6 * 33] * q), clamp127(s[7 * 33] * q));
            *(GAS u32x2*)((unsigned char*)d.WT + (size_t)(d.out_row0 + n) * d.K + d.k0 + 8 * c) = o; }
    } else if (d.f8) {
#pragma unroll
        for (int j = 0; j < 4; ++j) { const int n = (lane >> 3) + 8 * j; const LAS float* s = scr + (8 * c) * 33 + n;
            u32x2 o; o.x = pack4_fp8(s[0 * 33] * W8_SCALE, s[1 * 33] * W8_SCALE, s[2 * 33] * W8_SCALE, s[3 * 33] * W8_SCALE); o.y = pack4_fp8(s[4 * 33] * W8_SCALE, s[5 * 33] * W8_SCALE, s[6 * 33] * W8_SCALE, s[7 * 33] * W8_SCALE);
            __builtin_nontemporal_store(o, (GAS u32x2*)((unsigned char*)d.WT + (size_t)(d.out_row0 + n) * d.K + d.k0 + 8 * c)); }
    } else {
#pragma unroll
        for (int j = 0; j < 4; ++j) { const int n = (lane >> 3) + 8 * j; const LAS float* s = scr + (8 * c) * 33 + n;
            u32x4 o; o.x = cvtpk_s(s[0 * 33], s[1 * 33]); o.y = cvtpk_s(s[2 * 33], s[3 * 33]); o.z = cvtpk_s(s[4 * 33], s[5 * 33]); o.w = cvtpk_s(s[6 * 33], s[7 * 33]);
            *(GAS u32x4*)(d.WT + (size_t)(d.out_row0 + n) * d.K + d.k0 + 8 * c) = o; }
    }
    LDS_WAIT(); asm volatile("" ::: "memory");
}
#ifndef CONV_DEPTH
#define CONV_DEPTH 2
#endif
DI void convert_range(const Ptrs& P, int first, int end, int stride, LAS float* scr, int lane) {
    constexpr int DEPTH = CONV_DEPTH; f32x4 buf[DEPTH][8]; ItemDesc dsc[DEPTH];
#pragma unroll
    for (int q = 0; q < DEPTH - 1; ++q) { const int it = first + q * stride; dsc[q] = decode_item(P, it < end ? it : first); if (it < end) item_load(dsc[q], buf[q], lane); }
    for (int base = first; base < end; base += DEPTH * stride) {
#pragma unroll
        for (int q = 0; q < DEPTH; ++q) {
            const int it = base + q * stride; if (it >= end) return;
            const int pf = it + (DEPTH - 1) * stride; constexpr int dummy = 0; (void)dummy;
            if (pf < end) { dsc[(q + DEPTH - 1) % DEPTH] = decode_item(P, pf); item_load(dsc[(q + DEPTH - 1) % DEPTH], buf[(q + DEPTH - 1) % DEPTH], lane); }
            item_finish(dsc[q], buf[q], scr, lane);
        }
    }
}
DI float modv(const Ptrs& P, int b, int idx) { const float* m = P.mod + b * MODW + idx; return ((m[0] + m[NB * MODW]) + (m[2 * NB * MODW] + m[3 * NB * MODW])) + P.b_ada[idx]; }
DI void p0_prologue(Frame& F, const Ptrs& P) {
    LAS float* ca = (LAS float*)F.lds; LAS float* PP = (LAS float*)(F.lds + 65536);
    const int kg = F.tid >> 4, c4 = F.tid & 15; constexpr int NITM = 4 * (MODW / 64), NSCAN = D * INW / 4;
    const int gt = F.gw * 64 + F.lane, NGT = F.NGW * 64;
    f32x4 cv[8];
#pragma unroll
    for (int j = 0; j < 8; ++j) cv[j] = *(const GAS f32x4*)(P.c + 4 * (F.tid + NWAVES * 64 * j));
#define P0_LOADW(W_, ITEM_) do { const int chunk_ = (ITEM_) % (MODW / 64), kq_ = (ITEM_) / (MODW / 64); const float* wp_ = P.w_ada + (size_t)(512 * kq_ + kg) * MODW + 64 * chunk_ + 4 * c4; \
        _Pragma("unroll") for (int i = 0; i < 16; ++i) W_[i] = __builtin_nontemporal_load((const GAS f32x4*)(wp_ + (size_t)(32 * i) * MODW)); } while (0)
    int item = blockIdx.x; f32x4 w[16];
    if (item < NITM) P0_LOADW(w, item);
    float t_rg = 0.f, t_re = 0.f, t_sb = 0.f;
    if (gt < NG * D) t_rg = P.w_rg[(gt % D) * NG + gt / D];
    if (gt < NE * D) t_re = P.w_re[(gt % D) * NE + gt / D];
    if (gt < GH * CH * CH) t_sb = P.wsp[gt];
    const GAS f32x4* wsc = (const GAS f32x4*)P.w_in; int sbase = gt; f32x4 sv[7]; bool spend = false; float wm = 0.f;
#define P0_SCAN_ISSUE() do { _Pragma("unroll") for (int j = 0; j < 7; ++j) { const int idx_ = sbase + j * NGT; sv[j] = (INP_I8 && idx_ < NSCAN) ? wsc[idx_] : (f32x4){0.f, 0.f, 0.f, 0.f}; } sbase += 7 * NGT; spend = true; } while (0)
#define P0_SCAN_EAT() do { _Pragma("unroll") for (int j = 0; j < 7; ++j) wm = fmaxf(wm, fmaxf(fmaxf(fabsf(sv[j].x), fabsf(sv[j].y)), fmaxf(fabsf(sv[j].z), fabsf(sv[j].w)))); spend = false; } while (0)
    if (INP_I8 && sbase < NSCAN) P0_SCAN_ISSUE();
    asm volatile("" ::: "memory");
#pragma unroll
    for (int j = 0; j < 8; ++j) { f32x4 o; o.x = cv[j].x / (1.f + expf(-cv[j].x)); o.y = cv[j].y / (1.f + expf(-cv[j].y)); o.z = cv[j].z / (1.f + expf(-cv[j].z)); o.w = cv[j].w / (1.f + expf(-cv[j].w)); *(LAS f32x4*)(ca + 4 * (F.tid + NWAVES * 64 * j)) = o; }
    __syncthreads();
    while (item < NITM) {
        const int nitem = item + F.G; const bool has = nitem < NITM; f32x4 wn[16];
        if (has) P0_LOADW(wn, nitem);
        asm volatile("" ::: "memory");
        const int chunk = item % (MODW / 64), kq = item / (MODW / 64), kbase = 512 * kq;
        f32x4 acc[NB];
#pragma unroll
        for (int b = 0; b < NB; ++b) acc[b] = (f32x4){0.f, 0.f, 0.f, 0.f};
#pragma unroll
        for (int i = 0; i < 16; ++i) { const int k = kbase + kg + 32 * i;
#pragma unroll
            for (int b = 0; b < NB; ++b) acc[b] += w[i] * ca[b * D + k]; }
#pragma unroll
        for (int b = 0; b < NB; ++b) *(LAS f32x4*)(PP + (kg * 8 + b) * 64 + 4 * c4) = acc[b];
        __syncthreads();
        { const int b = F.tid >> 6, col = F.tid & 63; float sacc = 0.f;
#pragma unroll 8
          for (int k2 = 0; k2 < 32; ++k2) sacc += PP[(k2 * 8 + b) * 64 + col];
          P.mod[(size_t)kq * NB * MODW + b * MODW + 64 * chunk + col] = sacc; }
        __syncthreads();
        if (spend) { P0_SCAN_EAT(); if (sbase < NSCAN) P0_SCAN_ISSUE(); }
        asm volatile("" ::: "memory");
        if (has) {
#pragma unroll
            for (int i = 0; i < 16; ++i) w[i] = wn[i]; }
        item = nitem;
    }
    while (spend) { P0_SCAN_EAT(); if (sbase < NSCAN) P0_SCAN_ISSUE(); }
#undef P0_LOADW
#undef P0_SCAN_ISSUE
#undef P0_SCAN_EAT
    if constexpr (INP_I8) {
#pragma unroll
        for (int o = 1; o < 64; o <<= 1) wm = fmaxf(wm, __shfl_xor(wm, o));
        if (F.lane == 0) atomicMax(P.wmaxw, __float_as_uint(wm)); }
    if (gt < NG * D) P.wrgT[gt] = t_rg;
    if (gt < NE * D) P.wreT[gt] = t_re;
    if (gt < GH * CH * CH) P.wsb[gt] = f2bf(t_sb);
    for (int i = gt + NGT; i < NG * D; i += NGT) { const int g = i / D, k = i % D; P.wrgT[i] = P.w_rg[k * NG + g]; }
    for (int i = gt + NGT; i < NE * D; i += NGT) { const int ge = i / D, k = i % D; P.wreT[i] = P.w_re[k * NE + ge]; }
    for (int i = gt + NGT; i < GH * CH * CH; i += NGT) P.wsb[i] = f2bf(P.wsp[i]);
}
DI void p1_norm(Frame& F, const Ptrs& P) {
    LAS float* G1 = (LAS float*)F.lds; LAS float* H1 = G1 + D; constexpr int RPB = 64; const int lane = F.lane;
    for (int blk = blockIdx.x; blk < T / RPB; blk += F.G) {
        const int row_base = blk * RPB, b = row_base / S;
        f32x4 cur[8];
        { const GAS f32x4* xr = (const GAS f32x4*)(P.x + (size_t)(row_base + F.wave) * D) + lane;
#pragma unroll
          for (int j = 0; j < 8; ++j) cur[j] = __builtin_nontemporal_load(xr + 64 * j); }
        __syncthreads();
        for (int i = F.tid; i < D; i += NWAVES * 64) { G1[i] = P.g_mix_pre[i] * (1.f + modv(P, b, D + i)); H1[i] = modv(P, b, i); }
        __syncthreads();
        for (int rr = F.wave; rr < RPB; rr += NWAVES) {
            const int row = row_base + rr; f32x4 nxt[8];
            if (rr + NWAVES < RPB) { const GAS f32x4* xr = (const GAS f32x4*)(P.x + (size_t)(row + NWAVES) * D) + lane;
#pragma unroll
                for (int j = 0; j < 8; ++j) nxt[j] = __builtin_nontemporal_load(xr + 64 * j); }
            float ss = 0.f;
#pragma unroll
            for (int j = 0; j < 8; ++j) ss += (cur[j].x * cur[j].x + cur[j].y * cur[j].y) + (cur[j].z * cur[j].z + cur[j].w * cur[j].w);
            const float r = rsqrtf(wave_sum(ss) * (1.f / D) + EPS);
            if constexpr (INP_I8) {
                f32x4 av[8]; float amax = 1e-30f;
#pragma unroll
                for (int j = 0; j < 8; ++j) { const int col = 4 * lane + 256 * j; const f32x4 g = *(const LAS f32x4*)(G1 + col), sh = *(const LAS f32x4*)(H1 + col);
                    av[j] = cur[j] * r * g + sh; amax = fmaxf(amax, fmaxf(fmaxf(fabsf(av[j].x), fabsf(av[j].y)), fmaxf(fabsf(av[j].z), fabsf(av[j].w)))); }
#pragma unroll
                for (int o = 1; o < 64; o <<= 1) amax = fmaxf(amax, __shfl_xor(amax, o));
                const float qs = 127.f / amax; if (lane == 0) P.asc[row] = amax * (1.f / 127.f);
                GAS unsigned* o4 = (GAS unsigned*)((unsigned char*)P.A + (size_t)row * D) + lane;
#pragma unroll
                for (int j = 0; j < 8; ++j) o4[64 * j] = pack4_i8(av[j].x * qs, av[j].y * qs, av[j].z * qs, av[j].w * qs);
            } else {
            GAS u32x2* o8 = (GAS u32x2*)(P.A + (size_t)row * D) + lane;
#pragma unroll
            for (int j = 0; j < 8; ++j) { const int col = 4 * lane + 256 * j; const f32x4 g = *(const LAS f32x4*)(G1 + col), sh = *(const LAS f32x4*)(H1 + col);
                const f32x4 a = cur[j] * r * g + sh; u32x2 w; w.x = cvt_pk_bf16(a.x, a.y); w.y = cvt_pk_bf16(a.z, a.w); o8[64 * j] = w; }
            }
#pragma unroll
            for (int j = 0; j < 8; ++j) cur[j] = nxt[j];
        }
    }
    __syncthreads();
    { LAS float* scr = (LAS float*)(F.lds + F.wave * 16384); convert_range(P, F.gw, conv_split(F.G), F.NGW, scr, F.lane); }
}
DI int crow(int r, int hi) { return (r & 3) + 8 * (r >> 2) + 4 * hi; }
#define KSWZ(row, colB) ((row) * 256 + ((colB) ^ (((row) & 7) << 4)))
DI int vimg_off(int row, int ch) { return 2048 * (row >> 3) + 512 * (ch >> 2) + 64 * (row & 7) + 16 * ((ch & 3) ^ ((row >> 2) & 3)); }
DI s16x4 vtr(LAS const unsigned char* p) { return __builtin_bit_cast(s16x4, __builtin_amdgcn_ds_read_tr16_b64_v4i16((LAS v4i16_t*)p)); }
DI bf16x8 pack8(const f32x16& x, int s) {
    u32x4 p; p.x = cvtpk_s(x[8 * s + 0], x[8 * s + 1]); p.y = cvtpk_s(x[8 * s + 2], x[8 * s + 3]); p.z = cvtpk_s(x[8 * s + 4], x[8 * s + 5]); p.w = cvtpk_s(x[8 * s + 6], x[8 * s + 7]);
    return __builtin_bit_cast(bf16x8, p);
}
#define MFMA32(a, b, c) __builtin_amdgcn_mfma_f32_32x32x16_bf16((a), (b), (c), 0, 0, 0)
DI void attn_unit(Frame& F, const Ptrs& P, int b, int kvh, int pb) {
    const int tid = F.tid, lane = F.lane, w = F.wave, r32 = lane & 31, h = lane >> 5;
    const int hq = kvh * 4 + (w >> 1), p0 = pb * 64, qpos = p0 + 32 * (w & 1) + r32; const size_t trow = (size_t)b * S + qpos;
    LAS unsigned char* Kb = F.lds; LAS unsigned char* Vb = F.lds + 32768;
    bf16x8 qr[8]; { const bf16* qp = P.Z + trow * INW + OQ + hq * HD + 8 * h;
#pragma unroll
        for (int d0 = 0; d0 < 8; ++d0) qr[d0] = *(const bf16x8*)(qp + 16 * d0); }
    f32x16 o[4];
#pragma unroll
    for (int d0 = 0; d0 < 4; ++d0)
#pragma unroll
        for (int r = 0; r < 16; ++r) o[d0][r] = 0.f;
    float m_run = P.sink[hq] * LOG2E, l_run = 1.f;
    const int j_lo = p0 >= 128 ? 0 : (128 - p0) / 64, j_hi = (S - 64 - p0 + 128) / 64 < 4 ? (S - 64 - p0 + 128) / 64 : 4;
    const int sr = tid >> 4, sc = tid & 15;
    const bf16* kg = P.Z + ((size_t)b * S) * INW + OK_ + kvh * HD + sc * 8; const bf16* vg = P.Z + ((size_t)b * S) * INW + OV + kvh * HD + sc * 8;
    const int kst0 = KSWZ(sr, sc * 16), kst1 = KSWZ(sr + 32, sc * 16), vst0 = vimg_off(sr, sc), vst1 = vimg_off(sr + 32, sc);
    const int q4 = (lane & 15) >> 2, p4 = lane & 3, g16 = (lane >> 4) & 1;
    const int vb0 = 64 * (4 * h + q4) + 16 * ((2 * g16 + (p4 >> 1)) ^ h) + 8 * (p4 & 1), vb1 = 2048 + 64 * (4 * h + q4) + 16 * ((2 * g16 + (p4 >> 1)) ^ (h + 2)) + 8 * (p4 & 1);
    bf16x8 sk0, sk1, sv0, sv1;
#define ATT_LOAD(j) do { const size_t r0 = (size_t)(p0 - 128 + 64 * (j) + sr) * INW; sk0 = *(const bf16x8*)(kg + r0); sk1 = *(const bf16x8*)(kg + r0 + (size_t)32 * INW); sv0 = *(const bf16x8*)(vg + r0); sv1 = *(const bf16x8*)(vg + r0 + (size_t)32 * INW); } while (0)
#define ATT_WRITE(bi) do { *(LAS bf16x8*)(Kb + (bi) * 16384 + kst0) = sk0; *(LAS bf16x8*)(Kb + (bi) * 16384 + kst1) = sk1; *(LAS bf16x8*)(Vb + (bi) * 16384 + vst0) = sv0; *(LAS bf16x8*)(Vb + (bi) * 16384 + vst1) = sv1; } while (0)
    ATT_LOAD(j_lo); ATT_WRITE(0);
    __syncthreads();
    for (int j = j_lo; j <= j_hi; ++j) {
        const int cur = (j - j_lo) & 1;
        if (j < j_hi) ATT_LOAD(j + 1);
        LAS const unsigned char* Kc = Kb + cur * 16384; LAS const unsigned char* Vc = Vb + cur * 16384;
        f32x16 s0, s1;
#pragma unroll
        for (int r = 0; r < 16; ++r) { s0[r] = 0.f; s1[r] = 0.f; }
#pragma unroll
        for (int d0 = 0; d0 < 8; ++d0) { const bf16x8 a0 = *(const LAS bf16x8*)(Kc + KSWZ(r32, (d0 * 16 + h * 8) * 2)); s0 = MFMA32(a0, qr[d0], s0); }
#pragma unroll
        for (int d0 = 0; d0 < 8; ++d0) { const bf16x8 a1 = *(const LAS bf16x8*)(Kc + KSWZ(32 + r32, (d0 * 16 + h * 8) * 2)); s1 = MFMA32(a1, qr[d0], s1); }
        if (j == 0 || j == 4) { const int kbase = p0 - 128 + 64 * j - qpos;
#pragma unroll
            for (int r = 0; r < 16; ++r) { const int d0 = kbase + crow(r, h), d1 = d0 + 32; if (d0 < -WIN || d0 > WIN) s0[r] = -1e30f; if (d1 < -WIN || d1 > WIN) s1[r] = -1e30f; } }
        float pmax = s0[0];
#pragma unroll
        for (int r = 1; r < 16; ++r) pmax = fmaxf(pmax, s0[r]);
#pragma unroll
        for (int r = 0; r < 16; ++r) pmax = fmaxf(pmax, s1[r]);
        pmax = xmax32(pmax);
        pmax -= m_run;
        float dlt = 0.f;
        if (__any(pmax > 8.f)) { dlt = fmaxf(pmax, 0.f); const float alpha = __builtin_amdgcn_exp2f(-dlt); l_run *= alpha;
#pragma unroll
            for (int d0 = 0; d0 < 4; ++d0)
#pragma unroll
                for (int r = 0; r < 16; ++r) o[d0][r] *= alpha; }
        const float mn = m_run + dlt; m_run = mn;
        float ps = 0.f;
#pragma unroll
        for (int r = 0; r < 16; ++r) { s0[r] = __builtin_amdgcn_exp2f(s0[r] - mn); s1[r] = __builtin_amdgcn_exp2f(s1[r] - mn); ps += s0[r] + s1[r]; }
        ps = xsum32(ps); l_run += ps;
        const bf16x8 pb0 = pack8(s0, 0), pb1 = pack8(s0, 1), pb2 = pack8(s1, 0), pb3 = pack8(s1, 1);
#pragma unroll
        for (int d0 = 0; d0 < 4; ++d0) {
#define ATT_VF(ks) ({ const s16x4 lo_ = vtr(Vc + vb0 + 4096 * (ks) + 512 * d0), hi_ = vtr(Vc + vb1 + 4096 * (ks) + 512 * d0); (bf16x8){lo_[0], lo_[1], lo_[2], lo_[3], hi_[0], hi_[1], hi_[2], hi_[3]}; })
            const bf16x8 v0 = ATT_VF(0), v1 = ATT_VF(1), v2 = ATT_VF(2), v3 = ATT_VF(3);
            o[d0] = MFMA32(v0, pb0, o[d0]); o[d0] = MFMA32(v1, pb1, o[d0]); o[d0] = MFMA32(v2, pb2, o[d0]); o[d0] = MFMA32(v3, pb3, o[d0]);
        }
        if (j < j_hi) ATT_WRITE(cur ^ 1);
        __syncthreads();
    }
    const float inv = 1.f / l_run; float ss = 0.f; bf16* yp = P.Y + trow * D + hq * HD + 4 * h;
#pragma unroll
    for (int d0 = 0; d0 < 4; ++d0)
#pragma unroll
        for (int g4 = 0; g4 < 4; ++g4) { const float a = o[d0][4 * g4] * inv, b2 = o[d0][4 * g4 + 1] * inv, c = o[d0][4 * g4 + 2] * inv, d = o[d0][4 * g4 + 3] * inv; ss += (a * a + b2 * b2) + (c * c + d * d);
            if constexpr (OUT_F8) { *(unsigned*)((unsigned char*)P.Y + trow * D + hq * HD + 4 * h + 32 * d0 + 8 * g4) = pack4_fp8(a * YA_SCALE, b2 * YA_SCALE, c * YA_SCALE, d * YA_SCALE); } else { u32x2 wv; wv.x = cvt_pk_bf16(a, b2); wv.y = cvt_pk_bf16(c, d); *(u32x2*)(yp + 32 * d0 + 8 * g4) = wv; } }
    ss = xsum32(ss); if (h == 0) P.ssp[trow * SSPW + hq] = ss;
#undef ATT_LOAD
#undef ATT_WRITE
}
DI void gmlp_phase(Frame& F, const Ptrs& P) {
    constexpr int NGM = NB * (S / CH) * GH;
    const int tid = F.tid, lane = F.lane, w = F.wave, r32 = lane & 31, h = lane >> 5, ch = tid & 15;
    LAS unsigned char* VC = F.lds;
    const int q4 = (lane & 15) >> 2, p4 = lane & 3, g16 = (lane >> 4) & 1;
    const int vb0 = 64 * (4 * h + q4) + 16 * ((2 * g16 + (p4 >> 1)) ^ h) + 8 * (p4 & 1), vb1 = 2048 + 64 * (4 * h + q4) + 16 * ((2 * g16 + (p4 >> 1)) ^ (h + 2)) + 8 * (p4 & 1);
    const int p = 32 * (w & 3) + r32, dp = w >> 2;
    int u = blockIdx.x; if (u >= NGM) return;
    bf16x8 raw[4];
#define GM_DECODE(uu, hh_, t0_) const int hh_ = (uu) % GH; const size_t t0_ = (size_t)((uu) / (GH * (S / CH))) * S + (size_t)(((uu) / GH) % (S / CH)) * CH
#define GM_LOADV(hh_, t0_) do { _Pragma("unroll") for (int i = 0; i < 4; ++i) raw[i] = *(const bf16x8*)(P.Z + ((t0_) + (tid >> 4) + 32 * i) * INW + OVG + (hh_) * HD + 8 * ch); } while (0)
    { GM_DECODE(u, hh0, t00); GM_LOADV(hh0, t00); }
    for (;;) {
        GM_DECODE(u, hh, t0);
        const size_t trow = t0 + p;
        s16x4 uv[2][4]; { const bf16* up = P.Z + trow * INW + OU + hh * HD + 4 * h;
#pragma unroll
            for (int dd = 0; dd < 2; ++dd)
#pragma unroll
                for (int g4 = 0; g4 < 4; ++g4) uv[dd][g4] = *(const s16x4*)(up + 32 * (2 * dp + dd) + 8 * g4); }
        const float bias = P.bsp[hh * CH + p];
        const f32x4 g0 = *(const f32x4*)(P.gn + hh * HD + 8 * ch), g1 = *(const f32x4*)(P.gn + hh * HD + 8 * ch + 4);
#pragma unroll
        for (int i = 0; i < 4; ++i) { const int r = (tid >> 4) + 32 * i;
            float v[8]; float s1 = 0.f;
#pragma unroll
            for (int k = 0; k < 8; ++k) { v[k] = bf2f((bf16)raw[i][k]); s1 += v[k]; }
            s1 = sum16(s1);
            const float mu = s1 * (1.f / 128); float s2 = 0.f;
#pragma unroll
            for (int k = 0; k < 8; ++k) { v[k] -= mu; s2 += v[k] * v[k]; }
            s2 = sum16(s2);
            const float rs = rsqrtf(s2 * (1.f / 128) + EPS);
            u32x4 pk; pk.x = cvt_pk_bf16(v[0] * rs * g0.x, v[1] * rs * g0.y); pk.y = cvt_pk_bf16(v[2] * rs * g0.z, v[3] * rs * g0.w); pk.z = cvt_pk_bf16(v[4] * rs * g1.x, v[5] * rs * g1.y); pk.w = cvt_pk_bf16(v[6] * rs * g1.z, v[7] * rs * g1.w);
            *(LAS u32x4*)(VC + vimg_off(r, ch)) = pk; }
        __syncthreads();
        const int un = u + F.G; const bool has = un < NGM;
        if (has) { GM_DECODE(un, hhn, t0n); GM_LOADV(hhn, t0n); }
        const bf16* wrow = P.wsb + ((size_t)hh * CH + p) * CH + 4 * h;
        f32x16 acc[2];
#pragma unroll
        for (int dd = 0; dd < 2; ++dd)
#pragma unroll
            for (int r = 0; r < 16; ++r) acc[dd][r] = 0.f;
#pragma unroll
        for (int ks = 0; ks < 8; ++ks) { const s16x4 wl = *(const s16x4*)(wrow + 16 * ks), wh = *(const s16x4*)(wrow + 16 * ks + 8);
            const bf16x8 bfrag = (bf16x8){wl[0], wl[1], wl[2], wl[3], wh[0], wh[1], wh[2], wh[3]};
#pragma unroll
            for (int dd = 0; dd < 2; ++dd) { const int d0 = 2 * dp + dd; const s16x4 lo = vtr(VC + vb0 + 4096 * ks + 512 * d0), hi = vtr(VC + vb1 + 4096 * ks + 512 * d0);
                acc[dd] = MFMA32(((bf16x8){lo[0], lo[1], lo[2], lo[3], hi[0], hi[1], hi[2], hi[3]}), bfrag, acc[dd]); } }
        float ss = 0.f; bf16* yp = P.Y + trow * D + AW + hh * HD + 4 * h;
#pragma unroll
        for (int dd = 0; dd < 2; ++dd)
#pragma unroll
            for (int g4 = 0; g4 < 4; ++g4) { const int dof = 32 * (2 * dp + dd) + 8 * g4; const s16x4 u4 = uv[dd][g4];
                const float a = bf2f((bf16)u4[0]) * (acc[dd][4 * g4] + bias), b2 = bf2f((bf16)u4[1]) * (acc[dd][4 * g4 + 1] + bias), c2 = bf2f((bf16)u4[2]) * (acc[dd][4 * g4 + 2] + bias), d2 = bf2f((bf16)u4[3]) * (acc[dd][4 * g4 + 3] + bias);
                ss += (a * a + b2 * b2) + (c2 * c2 + d2 * d2); if constexpr (OUT_F8) { *(unsigned*)((unsigned char*)P.Y + trow * D + AW + hh * HD + 4 * h + dof) = pack4_fp8(a * YA_SCALE, b2 * YA_SCALE, c2 * YA_SCALE, d2 * YA_SCALE); } else { u32x2 wv; wv.x = cvt_pk_bf16(a, b2); wv.y = cvt_pk_bf16(c2, d2); *(u32x2*)(yp + dof) = wv; } }
        ss = xsum32(ss); if (h == 0) P.ssp[trow * SSPW + 8 + hh * 2 + dp] = ss;
        __syncthreads();
        if (!has) break;
        u = un;
    }
#undef GM_DECODE
#undef GM_LOADV
}
DI void p3_mixer(Frame& F, const Ptrs& P) {
    constexpr int NATT = NB * KVH * (S / 64);
    for (int u = blockIdx.x; u < NATT; u += F.G) { const int pb = u % (S / 64), kvh = (u / (S / 64)) % KVH, b = u / ((S / 64) * KVH); attn_unit(F, P, b, kvh, pb); }
    gmlp_phase(F, P);
}
DI void bf4_to_f(const u32x2 a, f32x4& v) { v.x = __uint_as_float(a.x << 16); v.y = __uint_as_float(a.x & 0xffff0000u); v.z = __uint_as_float(a.y << 16); v.w = __uint_as_float(a.y & 0xffff0000u); }
DI void p5_thin(Frame& F, const Ptrs& P) {
    LAS float* A1 = (LAS float*)F.lds; LAS float* A2 = A1 + D; LAS float* A3 = A2 + D; LAS float* WG = A3 + D;
    LAS unsigned* lcnt = (LAS unsigned*)(WG + NG * D); LAS unsigned* lbase = lcnt + NE; LAS unsigned* lent = lbase + NE; LAS float* lwt = (LAS float*)(lent + NE * 128);
    constexpr int RPB = 64; const int lane = F.lane;
    for (int i = F.tid; i < NG * D; i += NWAVES * 64) WG[i] = P.wrgT[i];
    for (int blk = blockIdx.x; blk < T / RPB; blk += F.G) {
        const int row_base = blk * RPB, b = row_base / S;
        u32x2 cm[8]; f32x4 cx[8];
        { const GAS u32x2* mr = (const GAS u32x2*)(P.MIX + (size_t)(row_base + F.wave) * D) + lane; const GAS f32x4* xr = (const GAS f32x4*)(P.x + (size_t)(row_base + F.wave) * D) + lane;
#pragma unroll
          for (int j = 0; j < 8; ++j) { cm[j] = __builtin_nontemporal_load(mr + 64 * j); cx[j] = __builtin_nontemporal_load(xr + 64 * j); } }
        __syncthreads();
        for (int i = F.tid; i < D; i += NWAVES * 64) { A1[i] = modv(P, b, 2 * D + i) * P.g_mix_post[i]; A2[i] = P.g_ffn_pre[i] * (1.f + modv(P, b, 4 * D + i)); A3[i] = modv(P, b, 3 * D + i); }
        if (F.tid < NE) lcnt[F.tid] = 0u;
        __syncthreads();
        for (int rr = F.wave; rr < RPB; rr += NWAVES) {
            const int row = row_base + rr; u32x2 nm[8]; f32x4 nx[8];
            if (rr + NWAVES < RPB) { const GAS u32x2* mr = (const GAS u32x2*)(P.MIX + (size_t)(row + NWAVES) * D) + lane; const GAS f32x4* xr = (const GAS f32x4*)(P.x + (size_t)(row + NWAVES) * D) + lane;
#pragma unroll
                for (int j = 0; j < 8; ++j) { nm[j] = __builtin_nontemporal_load(mr + 64 * j); nx[j] = __builtin_nontemporal_load(xr + 64 * j); } }
            f32x4 v[8]; float ss = 0.f;
#pragma unroll
            for (int j = 0; j < 8; ++j) { bf4_to_f(cm[j], v[j]); ss += (v[j].x * v[j].x + v[j].y * v[j].y) + (v[j].z * v[j].z + v[j].w * v[j].w); }
            float r = rsqrtf(wave_sum(ss) * (1.f / D) + EPS); ss = 0.f;
            GAS u32x2* ho = (GAS u32x2*)(P.HB + (size_t)row * D) + lane;
#pragma unroll
            for (int j = 0; j < 8; ++j) { const f32x4 a1 = *(const LAS f32x4*)(A1 + 4 * lane + 256 * j); v[j] = cx[j] + a1 * (v[j] * r); u32x2 hw; hw.x = cvt_pk_bf16(v[j].x, v[j].y); hw.y = cvt_pk_bf16(v[j].z, v[j].w); __builtin_nontemporal_store(hw, ho + 64 * j); ss += (v[j].x * v[j].x + v[j].y * v[j].y) + (v[j].z * v[j].z + v[j].w * v[j].w); }
            r = rsqrtf(wave_sum(ss) * (1.f / D) + EPS);
            float gl[4] = {0.f, 0.f, 0.f, 0.f}; GAS u32x2* fo = (GAS u32x2*)(P.A + (size_t)row * D) + lane;
#pragma unroll
            for (int j = 0; j < 8; ++j) { const int col = 4 * lane + 256 * j; const f32x4 a2 = *(const LAS f32x4*)(A2 + col), a3 = *(const LAS f32x4*)(A3 + col); v[j] = v[j] * r * a2 + a3;
                if constexpr (MOE_FP8) { ((GAS unsigned*)((unsigned char*)P.A + (size_t)row * D) + lane)[64 * j] = pack4_fp8(v[j].x, v[j].y, v[j].z, v[j].w); } else { u32x2 wv; wv.x = cvt_pk_bf16(v[j].x, v[j].y); wv.y = cvt_pk_bf16(v[j].z, v[j].w); fo[64 * j] = wv; }
#pragma unroll
                for (int g = 0; g < 4; ++g) { const f32x4 wg = *(const LAS f32x4*)(WG + g * D + col); gl[g] += (v[j].x * wg.x + v[j].y * wg.y) + (v[j].z * wg.z + v[j].w * wg.w); } }
            int gi = 0; float gmax = -1e30f;
#pragma unroll
            for (int g = 0; g < 4; ++g) { gl[g] = wave_sum(gl[g]) + P.b_rg[g]; if (gl[g] > gmax) { gmax = gl[g]; gi = g; } }
            float gsum = 0.f;
#pragma unroll
            for (int g = 0; g < 4; ++g) gsum += expf(gl[g] - gmax);
            const float gval = 1.f / gsum;
            float el[4] = {0.f, 0.f, 0.f, 0.f};
#pragma unroll
            for (int e = 0; e < 4; ++e) { const float* we = P.wreT + (size_t)(gi * EPG + e) * D;
#pragma unroll
                for (int j = 0; j < 8; ++j) { const f32x4 wv = *(const f32x4*)(we + 4 * lane + 256 * j); el[e] += (v[j].x * wv.x + v[j].y * wv.y) + (v[j].z * wv.z + v[j].w * wv.w); } }
            int e1 = 0; float m1 = -1e30f;
#pragma unroll
            for (int e = 0; e < 4; ++e) { el[e] = wave_sum(el[e]) + P.b_re[gi * EPG + e]; if (el[e] > m1) { m1 = el[e]; e1 = e; } }
            int e2 = 0; float m2 = -1e30f;
#pragma unroll
            for (int e = 0; e < 4; ++e) if (e != e1 && el[e] > m2) { m2 = el[e]; e2 = e; }
            const float p2 = expf(m2 - m1); const float w1 = gval / (1.f + p2), w2 = gval * p2 / (1.f + p2);
            if (lane == 0) {
                const int ea = gi * EPG + e1, eb = gi * EPG + e2;
                const unsigned pa = __hip_atomic_fetch_add(&lcnt[ea], 1u, __ATOMIC_RELAXED, __HIP_MEMORY_SCOPE_WORKGROUP); lent[ea * 128 + pa] = (unsigned)row * 2u; lwt[ea * 128 + pa] = w1;
                const unsigned pb = __hip_atomic_fetch_add(&lcnt[eb], 1u, __ATOMIC_RELAXED, __HIP_MEMORY_SCOPE_WORKGROUP); lent[eb * 128 + pb] = (unsigned)row * 2u + 1u; lwt[eb * 128 + pb] = w2;
            }
#pragma unroll
            for (int j = 0; j < 8; ++j) { cm[j] = nm[j]; cx[j] = nx[j]; }
        }
        __syncthreads();
        if (F.tid < NE) lbase[F.tid] = atomicAdd((unsigned*)P.ctlcnt + F.tid, lcnt[F.tid]);
        __syncthreads();
        for (int i = F.tid; i < NE * 128; i += NWAVES * 64) { const int e = i >> 7, k = i & 127; if ((unsigned)k < lcnt[e]) { const unsigned dst = lbase[e] + k; P.list[e * T + dst] = lent[i]; P.lw[e * T + dst] = lwt[i]; } }
    }
    __syncthreads();
}
DI void fp8x4_to_f(unsigned a, f32x4& v) { const f32x2 lo = __builtin_amdgcn_cvt_pk_f32_fp8((int)a, false), hi = __builtin_amdgcn_cvt_pk_f32_fp8((int)a, true); v.x = lo.x; v.y = lo.y; v.z = hi.x; v.w = hi.y; }
DI void p8_final(Frame& F, const Ptrs& P) {
    LAS float* A4 = (LAS float*)F.lds; constexpr int RPB = 64; const int lane = F.lane;
    typedef unsigned YT __attribute__((ext_vector_type(YK_FP8 ? 1 : 2)));
    constexpr int YROW = YK_FP8 ? D : 2 * D;
    for (int blk = blockIdx.x; blk < T / RPB; blk += F.G) {
        const int row_base = blk * RPB, b = row_base / S;
        YT c0[8], c1[8]; u32x2 ch[8];
#define P8_LOAD(Y0_, Y1_, H_, ROW_) do { const GAS YT* y0_ = (const GAS YT*)((const unsigned char*)P.YK + (size_t)(2 * (ROW_)) * YROW) + lane; const GAS YT* y1_ = (const GAS YT*)((const unsigned char*)P.YK + (size_t)(2 * (ROW_) + 1) * YROW) + lane; \
            const GAS u32x2* hr_ = (const GAS u32x2*)(P.HB + (size_t)(ROW_) * D) + lane; \
            _Pragma("unroll") for (int j = 0; j < 8; ++j) { Y0_[j] = __builtin_nontemporal_load(y0_ + 64 * j); Y1_[j] = __builtin_nontemporal_load(y1_ + 64 * j); H_[j] = __builtin_nontemporal_load(hr_ + 64 * j); } } while (0)
        P8_LOAD(c0, c1, ch, row_base + F.wave);
        __syncthreads();
        for (int i = F.tid; i < D; i += NWAVES * 64) A4[i] = modv(P, b, 5 * D + i) * P.g_ffn_post[i];
        __syncthreads();
        for (int rr = F.wave; rr < RPB; rr += NWAVES) {
            const int row = row_base + rr; YT n0[8], n1[8]; u32x2 nh[8];
            if (rr + NWAVES < RPB) P8_LOAD(n0, n1, nh, row + NWAVES);
            f32x4 v[8]; float ss = 0.f;
#pragma unroll
            for (int j = 0; j < 8; ++j) { f32x4 a, c;
                if constexpr (YK_FP8) { fp8x4_to_f(c0[j][0], a); fp8x4_to_f(c1[j][0], c); v[j] = (a + c) * (1.f / Y8_SCALE); }
                else { u32x2 t0, t1; t0.x = c0[j][0]; t0.y = c0[j][YK_FP8 ? 0 : 1]; t1.x = c1[j][0]; t1.y = c1[j][YK_FP8 ? 0 : 1]; bf4_to_f(t0, a); bf4_to_f(t1, c); v[j] = a + c; }
                ss += (v[j].x * v[j].x + v[j].y * v[j].y) + (v[j].z * v[j].z + v[j].w * v[j].w); }
            const float r = rsqrtf(wave_sum(ss) * (1.f / D) + EPS);
            GAS f32x4* ho = (GAS f32x4*)(P.out + (size_t)row * D) + lane;
#pragma unroll
            for (int j = 0; j < 8; ++j) { const f32x4 a4 = *(const LAS f32x4*)(A4 + 4 * lane + 256 * j); { f32x4 hv; bf4_to_f(ch[j], hv); __builtin_nontemporal_store(hv + a4 * (v[j] * r), ho + 64 * j); } }
#pragma unroll
            for (int j = 0; j < 8; ++j) { c0[j] = n0[j]; c1[j] = n1[j]; ch[j] = nh[j]; }
        }
#undef P8_LOAD
    }
}

struct Args { const void* in[23]; float* out; unsigned char* ws; int ph_lo, ph_hi; };
__global__ void __launch_bounds__(NWAVES * 64, 2) mega_fwd(Args args) {
    extern __shared__ __attribute__((aligned(16))) unsigned char lds[];
    Frame F;
    F.lds = (LAS unsigned char*)lds; F.MISC = (volatile LAS unsigned*)(F.lds + MISC_OFF);
    F.tid = threadIdx.x; F.lane = F.tid & 63; F.wave = __builtin_amdgcn_readfirstlane(F.tid >> 6); F.G = gridDim.x; F.gw = blockIdx.x * NWAVES + F.wave; F.NGW = F.G * NWAVES;
    unsigned char* ws = args.ws; F.ctl = (gu32*)(ws + WS_CTL);
#define PTRS(P) Ptrs P; { P.x = (const float*)args.in[0]; P.c = (const float*)args.in[1]; P.pos = (const int*)args.in[2]; P.w_ada = (const float*)args.in[3]; P.b_ada = (const float*)args.in[4]; P.g_mix_pre = (const float*)args.in[5]; \
    P.g_mix_post = (const float*)args.in[6]; P.w_in = (const float*)args.in[7]; P.sink = (const float*)args.in[8]; P.gn = (const float*)args.in[9]; P.wsp = (const float*)args.in[10]; P.bsp = (const float*)args.in[11]; \
    P.gg = (const float*)args.in[12]; P.w_out = (const float*)args.in[13]; P.g_ffn_pre = (const float*)args.in[14]; P.g_ffn_post = (const float*)args.in[15]; P.w_rg = (const float*)args.in[16]; P.b_rg = (const float*)args.in[17]; \
    P.w_re = (const float*)args.in[18]; P.b_re = (const float*)args.in[19]; P.w_gate = (const float*)args.in[20]; P.w_up = (const float*)args.in[21]; P.w_down = (const float*)args.in[22]; P.out = args.out; \
    P.mod = (float*)(ws + WS_MOD); P.rope = (float*)(ws + WS_ROPE); P.ssp = (float*)(ws + WS_SSP); P.list = (unsigned*)(ws + WS_LIST); P.lw = (float*)(ws + WS_LW); P.wrgT = (float*)(ws + WS_WRG); P.wreT = (float*)(ws + WS_WRE); \
    P.wsb = (bf16*)(ws + WS_WSB); P.WinT = (bf16*)(ws + WS_WIN); P.WoT = (bf16*)(ws + WS_WO); P.WguT = (bf16*)(ws + WS_WGU); P.WdT = (bf16*)(ws + WS_WD); P.A = (bf16*)(ws + WS_A); P.Z = (bf16*)(ws + WS_Z); P.Y = (bf16*)(ws + WS_Y); \
    P.MIX = (bf16*)(ws + WS_MIX); P.HB = (bf16*)(ws + WS_HB); P.ctlcnt = (unsigned*)(ws + WS_CTL) + CW_CNT; P.wmaxw = (unsigned*)(ws + WS_CTL) + CW_WMAX; P.asc = (float*)(ws + WS_ASC); P.HID = (bf16*)(ws + WS_HID); P.YK = (bf16*)(ws + WS_YK); }
    for (int u = F.tid; u < (LDS_BYTES - MISC_OFF) / 4; u += NWAVES * 64) ((LAS unsigned*)(F.lds + MISC_OFF))[u] = 0u;
    __syncthreads();
    const int lo = args.ph_lo, hi = args.ph_hi;
    XcdBarrier bar; bar.bar = (unsigned*)(F.ctl + CW_BAR); bar.x = 0; bar.st = nullptr;
    if (hi - lo > 1) bar = xcd_barrier_post((unsigned*)(F.ctl + CW_BAR), F.MISC + 24);
#define IN(k) (lo <= (k) && (k) < hi)
#define SEAM(k) do { if (IN(k) && IN((k) + 1)) xcd_barrier(bar); } while (0)
    LAS unsigned* tab = (LAS unsigned*)(F.lds + TAB_OFF); LAS int* tp = (LAS int*)(F.lds + MISC_OFF);

    if (IN(0)) { PTRS(P); p0_prologue(F, P); } SEAM(0);
    if (IN(1)) { PTRS(P); p1_norm(F, P); } SEAM(1);
    if (IN(2)) { PTRS(P); const int ncv = conv_wgs(F.G), gg2 = F.G - ncv;
        if ((int)blockIdx.x < gg2) { pg8::DenseOrder S2; S2.init(P.A, P.WinT, T, INW, INP_I8 ? D / 2 : D, gg2, (int)blockIdx.x);
            LAS f32x2* rt2 = (LAS f32x2*)tab; const float wq = INP_I8 ? __uint_as_float(__hip_atomic_load(P.wmaxw, RLX_AGENT)) * (1.f / 127.f) : 1.f;
            for (int idx = F.tid; idx < 4 * 256; idx += NWAVES * 64) { pg8::Unit u; if (S2.next(idx >> 8, u)) { const int row = u.pm * 256 + (idx & 255); rt2[idx] = (f32x2){INP_I8 ? P.asc[row] * wq : 1.f, (float)P.pos[row]}; } }
            __syncthreads();
            pg8::EpiInproj E{P.Z, rt2};
            pg8::gemm_core<pg8::EpiInproj, pg8::DenseOrder, false, false, INP_I8 ? 2 : 0>(F.lds, S2, E, nullptr); }
        else { LAS float* scr = (LAS float*)(F.lds + F.wave * 16384); const int per = CONV_ITEMS / (ncv * NWAVES), f0 = P0_SPLIT + (((int)blockIdx.x - gg2) * NWAVES + F.wave) * per; convert_range(P, f0, f0 + per, 1, scr, F.lane); } } SEAM(2);
    if (IN(3)) { PTRS(P); p3_mixer(F, P); } SEAM(3);
    if (IN(4)) { PTRS(P); pg8::DenseOrder S4; S4.init(P.Y, P.WoT, T, D, OUT_F8 ? D / 2 : D, F.G, (int)blockIdx.x);
        LAS f32x2* rr = (LAS f32x2*)tab; LAS unsigned* gt4 = tab + 4 * 512; pg8::Unit u; S4.gather = OUT_F8 != 0;
        for (int i = 0; i < 4 && S4.next(i, u); ++i) { f32x4 v[4];
#pragma unroll
            for (int j = 0; j < 4; ++j) { const int idx = F.tid + NWAVES * 64 * j; v[j] = ((idx & 7) < 6) ? *(const f32x4*)(P.ssp + (size_t)(u.pm * 256 + (idx >> 3)) * SSPW + 4 * (idx & 7)) : (f32x4){0.f, 0.f, 0.f, 0.f}; }
#pragma unroll
            for (int j = 0; j < 4; ++j) { const int idx = F.tid + NWAVES * 64 * j, r = idx >> 3, q = idx & 7; const float s = (v[j].x + v[j].y) + (v[j].z + v[j].w); float sa = q < 2 ? s : 0.f, sg = q < 2 ? 0.f : s;
                sa += __shfl_xor(sa, 1); sg += __shfl_xor(sg, 1); sg += __shfl_xor(sg, 2); sg += __shfl_xor(sg, 4);
                if (q == 0) { const float ra = rsqrtf(sa * (1.f / AW) + EPS), rg = rsqrtf(sg * (1.f / AW) + EPS); rr[i * 256 + r] = (f32x2){ra / rg, rg}; gt4[i * 256 + r] = (unsigned)(u.pm * 256 + r) * (unsigned)D; } } }
        __syncthreads();
        pg8::EpiOutproj E{P.MIX, rr};
        if constexpr (OUT_F8) pg8::gemm_core<pg8::EpiOutproj, pg8::DenseOrder, true, true, 1>(F.lds, S4, E, gt4);
        else pg8::gemm_core<pg8::EpiOutproj, pg8::DenseOrder, false, true, 0>(F.lds, S4, E, nullptr); } SEAM(4);
    if (IN(5)) { PTRS(P); p5_thin(F, P); } SEAM(5);
    if (IN(6) || IN(7)) {
        if (F.tid == 0) { int o = 0; for (int e = 0; e < NE; ++e) { tp[e] = o; o += (int)((__hip_atomic_load(F.ctl + CW_CNT + e, RLX_AGENT) + 255u) >> 8); } tp[NE] = o; }
        __syncthreads();
    }
    if (IN(6)) { PTRS(P); pg8::MoeOrder S6{(const char*)P.A, (const char*)P.WguT, MOE_FP8 ? D / 2 : D, FF / 128, (size_t)2048 * 2048 * (MOE_FP8 ? 1 : 2), tp, F.G, (int)blockIdx.x, true};
        LAS unsigned* gt = tab; LAS float* wt = (LAS float*)(tab + MAX_SLOTS * 256); pg8::Unit u;
#pragma unroll
        for (int j = 0; j < 4; ++j) { const int idx = F.tid + NWAVES * 64 * j, i = idx >> 8, r = idx & 255;
            if (i < MAX_SLOTS && S6.next(i, u)) { const unsigned n = __hip_atomic_load(F.ctl + CW_CNT + u.e, RLX_AGENT); const unsigned m = (unsigned)u.pm * 256u + r;
                const bool ok = m < n; gt[i * 256 + r] = ok ? (P.list[u.e * T + m] >> 1) * (unsigned)(MOE_FP8 ? D : D * 2) : 0u; wt[i * 256 + r] = ok ? P.lw[u.e * T + m] : 0.f; } }
        __syncthreads();
        pg8::EpiGateUp E{(unsigned char*)P.HID, wt, tp}; pg8::gemm_core<pg8::EpiGateUp, pg8::MoeOrder, true, false, MOE_FP8 ? 1 : 0>(F.lds, S6, E, gt);
        if (conv_wgs(F.G)) {
            LAS float* scr = (LAS float*)(F.lds + F.wave * 16384); const int nmax = S6.max_units();
            int nidle = 0, myidx = -1;
            if (S6.xcd()) { const int W = F.G >> 3, mx = (int)blockIdx.x & 7, mr = (int)blockIdx.x >> 3;
                for (int x = 0; x < 8; ++x) { const int U = S6.group_units(x), q = (U + W - 1) / W; const int first = (q < nmax) ? 0 : U - (nmax - 1) * W;
                    if (x == mx && mr >= first) myidx = nidle + (mr - first); nidle += W - first; } }
            else { const int rem = (tp[NE] * (FF / 128)) % F.G; if (rem != 0) { nidle = F.G - rem; if ((int)blockIdx.x >= rem) myidx = (int)blockIdx.x - rem; } }
            if (nidle < 96) convert_range(P, I_DOWN0 + F.gw, NITEMS, F.NGW, scr, F.lane);
            else if (myidx >= 0) convert_range(P, I_DOWN0 + myidx * NWAVES + F.wave, NITEMS, nidle * NWAVES, scr, F.lane);
        } } SEAM(6);
    if (IN(7)) { PTRS(P); pg8::MoeOrder S7{(const char*)P.HID, (const char*)P.WdT, MOE_FP8 ? FF / 2 : FF, D / 256, (size_t)2048 * 1024 * (MOE_FP8 ? 1 : 2), tp, F.G, (int)blockIdx.x, true};
        LAS unsigned* dt = tab; LAS unsigned* gt7 = tab + MAX_SLOTS * 256; pg8::Unit u;
#pragma unroll
        for (int j = 0; j < 4; ++j) { const int idx = F.tid + NWAVES * 64 * j, i = idx >> 8, r = idx & 255;
            if (i < MAX_SLOTS && S7.next(i, u)) { const unsigned n = __hip_atomic_load(F.ctl + CW_CNT + u.e, RLX_AGENT); const unsigned m = (unsigned)u.pm * 256u + r;
                dt[i * 256 + r] = m < n ? P.list[u.e * T + m] : 0xffffffffu; gt7[i * 256 + r] = (unsigned)((tp[u.e] + u.pm) * 256 + r) * (unsigned)(MOE_FP8 ? FF : FF * 2); } }
        __syncthreads();
        pg8::EpiDown E{(unsigned char*)P.YK, dt}; pg8::gemm_core<pg8::EpiDown, pg8::MoeOrder, true, false, MOE_FP8 ? 1 : 0>(F.lds, S7, E, gt7); } SEAM(7);
    if (IN(8)) { PTRS(P); p8_final(F, P);
        if (__hip_atomic_load(F.ctl + CW_BAR + XB_TMO, RLX_AGENT) != 0u) { const float q = __builtin_nanf(""); for (int row = F.gw; row < T; row += F.NGW) for (int j = F.lane; j < D; j += 64) P.out[(size_t)row * D + j] = q; } }
#undef IN
#undef SEAM
}

extern "C" void kernel_launch(void* const* d_in, const int* in_sizes, int n_in, void* d_out, int out_size, void* d_ws, size_t ws_size, hipStream_t stream) {
    static int grid = 0;
    if (grid == 0) {
        if (n_in != 23 || in_sizes[0] != T * D || out_size != T * D || ws_size < WS_END) { fprintf(stderr, "kernel_launch: unexpected shapes / workspace (%d inputs, ws %zu)\n", n_in, ws_size); grid = -1; return; }
        int dev = 0, cus = 0, per_cu = 0;
        if (hipGetDevice(&dev) != hipSuccess || hipDeviceGetAttribute(&cus, hipDeviceAttributeMultiprocessorCount, dev) != hipSuccess) { grid = -1; return; }
        if (hipFuncSetAttribute((const void*)mega_fwd, hipFuncAttributeMaxDynamicSharedMemorySize, LDS_BYTES) != hipSuccess) { grid = -1; return; }
        if (hipOccupancyMaxActiveBlocksPerMultiprocessor(&per_cu, (const void*)mega_fwd, NWAVES * 64, LDS_BYTES) != hipSuccess || per_cu < 1) fprintf(stderr, "kernel_launch: occupancy query says %d\n", per_cu);
        (void)hipGetLastError();
        grid = cus;
        if (grid != 256) fprintf(stderr, "kernel_launch: %d CUs (built for 256)\n", grid);
    }
    if (grid < 0) return;
    (void)hipMemsetAsync((char*)d_ws + WS_CTL, 0, CTL_ZERO_BYTES, stream);
    Args a; memset(&a, 0, sizeof(a));
    for (int i = 0; i < 23; ++i) a.in[i] = d_in[i];
    a.out = (float*)d_out; a.ws = (unsigned char*)d_ws; a.ph_lo = 0; a.ph_hi = 9;
    hipLaunchKernelGGL(mega_fwd, dim3(grid), dim3(NWAVES * 64), LDS_BYTES, stream, a);
}
```

```cpp
#include <hip/hip_runtime.h>
#include <cstdio>
#include <cstdint>
#include <cstring>

#ifndef MOE_FP8
#define MOE_FP8 1
#endif

constexpr int D = 2048, NB = 8, S = 2048, T = NB * S, HD = 128, AW = 1024, AH = 8, KVH = 2, GH = 8, INW = 3584;
constexpr int WIN = 128, CH = 128, NG = 4, EPG = 4, NE = 16, FF = 1024, NMOD = 6, MODW = NMOD * D;
constexpr int OQ = 0, OK_ = 1024, OV = 1280, OU = 1536, OVG = 2560;
constexpr float EPS = 1e-6f;
constexpr float LOG2E = 1.4426950408889634f;
constexpr float C2 = 0.08838834764831845f * LOG2E;
constexpr int HID_ROWS = 2 * T + NE * 256;
constexpr int SSPW = 32;

typedef unsigned short bf16;
typedef short bf16x8 __attribute__((ext_vector_type(8)));
typedef short s16x4 __attribute__((ext_vector_type(4)));
typedef short v4i16_t __attribute__((ext_vector_type(4)));
typedef float f32x2 __attribute__((ext_vector_type(2)));
typedef float f32x4 __attribute__((ext_vector_type(4)));
typedef float f32x16 __attribute__((ext_vector_type(16)));
typedef unsigned u32x2 __attribute__((ext_vector_type(2)));
typedef unsigned u32x4 __attribute__((ext_vector_type(4)));
#define DI __device__ __forceinline__
#define GAS __attribute__((address_space(1)))
#define LAS __attribute__((address_space(3)))
typedef GAS unsigned gu32;

constexpr size_t MiB = 1u << 20;
constexpr size_t WS_CTL = 0, CTL_ZERO_BYTES = 65536;
constexpr size_t WS_MOD = 1 * MiB;
constexpr size_t WS_ROPE = 3 * MiB;
constexpr size_t WS_SSP = 5 * MiB;
constexpr size_t WS_LIST = 7 * MiB;
constexpr size_t WS_LW = 8 * MiB;
constexpr size_t WS_WRG = 9 * MiB;
constexpr size_t WS_WRE = 9 * MiB + 65536;
constexpr size_t WS_WSB = 9 * MiB + 262144;
constexpr size_t WS_ASC = 9 * MiB + 786432;
constexpr size_t WS_WIN = 10 * MiB;
constexpr size_t WS_WO = 24 * MiB;
constexpr size_t WS_WGU = 32 * MiB;
constexpr size_t WS_WD = 160 * MiB;
constexpr size_t WS_A = 224 * MiB;
constexpr size_t WS_Z = 288 * MiB;
constexpr size_t WS_Y = 400 * MiB;
constexpr size_t WS_HB = 400 * MiB;
constexpr size_t WS_MIX = 464 * MiB;
constexpr size_t WS_HID = 288 * MiB;
constexpr size_t WS_YK = 464 * MiB;
constexpr size_t WS_END = 592 * MiB;
constexpr int CW_TMO = 0, CW_CNT = 64, CW_WMAX = 96, CW_BAR = 4096;

DI float bf2f(bf16 h) { return __uint_as_float(((unsigned)h) << 16); }
DI bf16 f2bf(float f) { unsigned u = __float_as_uint(f); return (bf16)((u + 0x7fffu + ((u >> 16) & 1u)) >> 16); }
DI unsigned cvt_pk_bf16(float lo, float hi) { unsigned r; asm volatile("v_cvt_pk_bf16_f32 %0, %1, %2" : "=v"(r) : "v"(lo), "v"(hi)); return r; }
typedef float f32x2_t __attribute__((ext_vector_type(2))); typedef __bf16 bf16x2_t __attribute__((ext_vector_type(2)));
DI unsigned cvtpk_s(float lo, float hi) { f32x2_t v = {lo, hi}; bf16x2_t b = __builtin_convertvector(v, bf16x2_t); return __builtin_bit_cast(unsigned, b); }
DI unsigned pack4_i8(float a, float b, float c, float d) { const int q0 = (int)rintf(a), q1 = (int)rintf(b), q2 = (int)rintf(c), q3 = (int)rintf(d); return (unsigned)(q0 & 255) | ((unsigned)(q1 & 255) << 8) | ((unsigned)(q2 & 255) << 16) | ((unsigned)q3 << 24); }
DI float clamp127(float v) { return __builtin_amdgcn_fmed3f(v, -127.f, 127.f); }
DI u32x4 pair16(u32x2 a, u32x2 b) { const auto r0 = __builtin_amdgcn_permlane16_swap(a.x, b.x, false, false); const auto r1 = __builtin_amdgcn_permlane16_swap(a.y, b.y, false, false); return (u32x4){r0[0], r1[0], r0[1], r1[1]}; }
constexpr float W8_SCALE = 32.f, H8_SCALE = 16.f, Y8_SCALE = 64.f, YA_SCALE = 4.f;
DI unsigned dpp_ror8(unsigned v) { return (unsigned)__builtin_amdgcn_update_dpp(0, (int)v, 0x128, 0xF, 0xF, true); }
DI void rows8_store(bf16* base  , size_t pitch, int fr, const u32x4 w0, const u32x4 w1) {
    const u32x4 x = {dpp_ror8(w1.x), dpp_ror8(w1.y), dpp_ror8(w1.z), dpp_ror8(w1.w)}; const bool hi = fr >= 8;
    const u32x4 a = hi ? x : w0, b = hi ? w0 : x;
    bf16* pa = base + (size_t)(fr & 7) * pitch + (hi ? 32 : 0); bf16* pb = base + (size_t)((fr & 7) + 8) * pitch + (hi ? 0 : 32);
    *(u32x4*)pa = a; *(u32x4*)pb = b;
}
DI float clamp8(float v) { return __builtin_amdgcn_fmed3f(v, -448.f, 448.f); }
DI unsigned pack4_fp8(float a, float b, float c, float d) { int p = 0; p = __builtin_amdgcn_cvt_pk_fp8_f32(clamp8(a), clamp8(b), p, false); p = __builtin_amdgcn_cvt_pk_fp8_f32(clamp8(c), clamp8(d), p, true); return (unsigned)p; }
typedef int v4i32 __attribute__((ext_vector_type(4))); typedef int v8i32 __attribute__((ext_vector_type(8)));
DI v8i32 cat8(bf16x8 lo, bf16x8 hi) { const v4i32 a = __builtin_bit_cast(v4i32, lo), b = __builtin_bit_cast(v4i32, hi); return __builtin_shufflevector(a, b, 0, 1, 2, 3, 4, 5, 6, 7); }
#define DPP_ADD(v, ctrl) (v) += __builtin_bit_cast(float, __builtin_amdgcn_update_dpp(0, __builtin_bit_cast(int, (v)), (ctrl), 0xF, 0xF, true))
DI float wave_sum(float v) {
    DPP_ADD(v, 0x111); DPP_ADD(v, 0x112); DPP_ADD(v, 0x114); DPP_ADD(v, 0x118);
    const int b = __builtin_bit_cast(int, v);
    return (__builtin_bit_cast(float, __builtin_amdgcn_readlane(b, 15)) + __builtin_bit_cast(float, __builtin_amdgcn_readlane(b, 31))) + (__builtin_bit_cast(float, __builtin_amdgcn_readlane(b, 47)) + __builtin_bit_cast(float, __builtin_amdgcn_readlane(b, 63)));
}
DI float sum16(float v) {
    DPP_ADD(v, 0xB1); DPP_ADD(v, 0x4E); DPP_ADD(v, 0x141); DPP_ADD(v, 0x140); return v;
}
DI float xsum32(float v) { const auto rr = __builtin_amdgcn_permlane32_swap(__float_as_uint(v), __float_as_uint(v), false, false); return __uint_as_float(rr[0]) + __uint_as_float(rr[1]); }
DI float xmax32(float v) { const auto rr = __builtin_amdgcn_permlane32_swap(__float_as_uint(v), __float_as_uint(v), false, false); return fmaxf(__uint_as_float(rr[0]), __uint_as_float(rr[1])); }
DI float xother32(float v) { const unsigned b = __float_as_uint(v); const auto rr = __builtin_amdgcn_permlane32_swap(b, b, false, false); return __uint_as_float(rr[0] ^ rr[1] ^ b); }
DI f32x2 gelu_pk(f32x2 v) {
    const f32x2 av = __builtin_elementwise_abs(v), d = av * 0.2316418882f + 1.0f;
    f32x2 t; t.x = __builtin_amdgcn_rcpf(d.x); t.y = __builtin_amdgcn_rcpf(d.y);
    f32x2 q = t * 0.5307027145f + (-0.7265760135f); q = q * t + 0.7107068705f; q = q * t + (-0.142248368f); q = q * t + 0.127414796f; q = q * t;
    const f32x2 s = (v * v) * (-0.72134752044f);
    f32x2 e; e.x = __builtin_amdgcn_exp2f(s.x); e.y = __builtin_amdgcn_exp2f(s.y);
    const f32x2 m = v * (q * e), r = v - m;
    f32x2 o; o.x = v.x < 0.f ? m.x : r.x; o.y = v.y < 0.f ? m.y : r.y; return o;
}
#define LDS_WAIT() asm volatile("s_waitcnt lgkmcnt(0)" ::: "memory")
#define VM_WAIT() asm volatile("s_waitcnt vmcnt(0)" ::: "memory")
#define RLX_AGENT __ATOMIC_RELAXED, __HIP_MEMORY_SCOPE_AGENT

namespace pg8 {
constexpr int BM = 256, BK = 64, HALF = 128, HTB = HALF * BK * 2, NXCD = 8, WGM = 8;
__host__ __device__ __forceinline__ int lds_byte(int r, int c) { const int st = (r >> 4) * 2 + (c >> 5), rr = r & 15, cc = c & 31, ob = rr * 64 + cc * 2; return st * 1024 + (ob ^ (((ob >> 9) & 1) << 5)); }
__host__ __device__ __forceinline__ void stage_rc(int b, int& R, int& C) { const int st = b / 1024, sb = b % 1024, swz = sb ^ (((sb >> 9) & 1) << 5); R = (st >> 1) * 16 + swz / 64; C = (st & 1) * 32 + (swz % 64) / 2; }
__host__ __device__ __forceinline__ int perm32(int rho) { const int n = rho >> 4, i = rho & 15; return 8 * (i >> 2) + 4 * n + (i & 3); }

struct Unit { int pm, pn, e, slot; };

struct DenseOrder {
    const char* A; const char* Bt; int K; int nM, nN, nwg, G, c;
    DI void init(const void* A_, const void* Bt_, int M, int N, int K_, int G_, int c_) { A = (const char*)A_; Bt = (const char*)Bt_; K = K_; nM = M / BM; nN = N / BM; nwg = nM * nN; G = G_; c = c_; }
    DI bool next(int i, Unit& u) const {
        const long L = (long)i * G + c; if (L >= nwg) return false;
        int wgid = (int)L; { const int q = nwg / NXCD, r = nwg % NXCD, xcd = wgid % NXCD, off = wgid / NXCD; wgid = (xcd < r ? xcd * (q + 1) : r * (q + 1) + (xcd - r) * q) + off; }
        const int nig = WGM * nN, gid = wgid / nig, fm = gid * WGM, gsz = (nM - fm) < WGM ? (nM - fm) : WGM;
        u.pm = fm + ((wgid % nig) % gsz); u.pn = (wgid % nig) / gsz; u.e = 0; u.slot = i; return true;
    }
    bool gather = false;
    DI const char* a_base(const Unit& u) const { return gather ? A : A + (size_t)u.pm * BM * K * 2; }
    DI const char* b_base(const Unit& u) const { return Bt + (size_t)u.pn * BM * K * 2; }
};
#ifndef INP_I8
#define INP_I8 1
#endif
#ifndef OUT_F8
#define OUT_F8 1
#endif
#ifndef YK_FP8
#define YK_FP8 1
#endif
#ifndef MOE_XCD
#define MOE_XCD 0
#endif
struct MoeOrder {
    const char* A; const char* Bt; int K, nN; size_t bstride  ; LAS const int* tp; int G, c; bool gather;
    DI bool xcd() const { return MOE_XCD && (G % 8 == 0); }
    DI int group_units(int x) const { return ((tp[x + 1] - tp[x]) + (tp[x + 9] - tp[x + 8])) * nN; }
    DI int my_units() const {
        if (xcd()) { const int W = G >> 3, r = c >> 3, U = group_units(c & 7); return U > r ? (U - r + W - 1) / W : 0; }
        const int tot = tp[NE] * nN; return tot > c ? (tot - c + G - 1) / G : 0;
    }
    DI int max_units() const {
        if (xcd()) { const int W = G >> 3; int m = 0;
#pragma unroll
            for (int x = 0; x < 8; ++x) { const int q = (group_units(x) + W - 1) / W; m = q > m ? q : m; } return m; }
        return (tp[NE] * nN + G - 1) / G;
    }
    DI bool next(int i, Unit& u) const {
        if (xcd()) {
            const int x = c & 7, r = c >> 3, W = G >> 3; const int t0 = tp[x + 1] - tp[x], t1 = tp[x + 9] - tp[x + 8];
            int k = r + W * i; if (k >= (t0 + t1) * nN) return false;
            int e = x; if (k >= t0 * nN) { e = x + 8; k -= t0 * nN; }
            u.e = e; u.pm = k / nN; u.pn = k % nN; u.slot = i; return true;
        }
        const int L = i * G + c; const int tot = tp[NE] * nN; if (L >= tot) return false;
        const int mt = L / nN; u.pn = L % nN; int e = 0;
#pragma unroll
        for (int k = 1; k < NE; ++k) e += (mt >= tp[k]) ? 1 : 0;
        u.e = e; u.pm = mt - tp[e]; u.slot = i; return true;
    }
    DI const char* a_base(const Unit& u) const { return gather ? A : A + (size_t)(tp[u.e] + u.pm) * BM * K * 2; }
    DI const char* b_base(const Unit& u) const { return Bt + (size_t)u.e * bstride + (size_t)u.pn * BM * K * 2; }
};

template <class Epi, class Sched, bool GATHER, bool MIDK, int QM = 0>
DI void gemm_core(LAS unsigned char* lds, const Sched& S, const Epi& E, LAS const unsigned* gtab) {
    const int tid = threadIdx.x, wid = __builtin_amdgcn_readfirstlane(tid >> 6), lane = tid & 63, wr = wid >> 2, wc = wid & 3, fr = lane & 15, fq = lane >> 4;
    const int K = S.K, nt = K / BK;
    unsigned voffA[2], voffB[2]; int RA[2];
#pragma unroll
    for (int i = 0; i < 2; ++i) { int R, C; stage_rc(tid * 16 + i * 8192, R, C); const int Rb = Epi::PERM ? (64 * (R >> 5) + perm32(R & 31)) : R;
        RA[i] = R; voffA[i] = GATHER ? (unsigned)(C * 2) : (unsigned)(R * K + C) * 2u; voffB[i] = (unsigned)(Rb * K + C) * 2u; }
    const size_t kstep = (size_t)(BK * 2);
    const size_t hstep = (size_t)HALF * K * 2;
    const size_t bhstep = Epi::PERM ? (size_t)32 * K * 2 : hstep;
    const unsigned ldsw = (unsigned)wid * 1024u;
    const int aoff = lds_byte(wr * 64 + fr, fq * 8), boff = lds_byte(wc * 32 + fr, fq * 8);
#define PG8_SA(b, h) (((b) * 2 + (h)) * HTB)
#define PG8_SB(b, h) ((4 + (b) * 2 + (h)) * HTB)
#define PG8_STAGE(bufoff, gbase, voff) do { _Pragma("unroll") for (int _i = 0; _i < 2; ++_i) \
        __builtin_amdgcn_global_load_lds((const unsigned*)((const char*)(gbase) + (voff)[_i]), (LAS unsigned*)(lds + (bufoff) + ldsw + _i * 8192), 16, 0, 0); } while (0)
#define PG8_STAGE_A(bufoff, kb, h, VA) do { if constexpr (GATHER) { PG8_STAGE(bufoff, kb, VA[h]); } else { PG8_STAGE(bufoff, (kb) + (h) * hstep, voffA); } } while (0)
#define PG8_LDA(dst, b, h) do { _Pragma("unroll") for (int m = 0; m < 4; ++m) _Pragma("unroll") for (int k = 0; k < 2; ++k) dst[m][k] = *(const LAS bf16x8*)(lds + PG8_SA(b, h) + aoff + m * 2048 + k * 1024); } while (0)
#define PG8_LDB(dst, b, h) do { _Pragma("unroll") for (int n = 0; n < 2; ++n) _Pragma("unroll") for (int k = 0; k < 2; ++k) dst[n][k] = *(const LAS bf16x8*)(lds + PG8_SB(b, h) + boff + n * 2048 + k * 1024); } while (0)
#define PG8_MMA(ai, bj, At, Bt) do { __builtin_amdgcn_s_setprio(1); _Pragma("unroll") for (int m = 0; m < 4; ++m) _Pragma("unroll") for (int n = 0; n < 2; ++n) { \
        if constexpr (QM == 1) acc[ai][bj][m][n] = __builtin_amdgcn_mfma_scale_f32_16x16x128_f8f6f4(cat8(Bt[n][0], Bt[n][1]), cat8(At[m][0], At[m][1]), acc[ai][bj][m][n], 0, 0, 0, 0x7f7f7f7f, 0, 0x7f7f7f7f); \
        else if constexpr (QM == 2) { _Pragma("unroll") for (int k = 0; k < 2; ++k) acc[ai][bj][m][n] = __builtin_bit_cast(f32x4, __builtin_amdgcn_mfma_i32_16x16x64_i8(__builtin_bit_cast(v4i32, Bt[n][k]), __builtin_bit_cast(v4i32, At[m][k]), __builtin_bit_cast(v4i32, acc[ai][bj][m][n]), 0, 0, 0)); } \
        else { _Pragma("unroll") for (int k = 0; k < 2; ++k) acc[ai][bj][m][n] = __builtin_amdgcn_mfma_f32_16x16x32_bf16(Bt[n][k], At[m][k], acc[ai][bj][m][n], 0, 0, 0); } } __builtin_amdgcn_s_setprio(0); } while (0)
#define PG8_WAIT_V(n) asm volatile("s_waitcnt vmcnt(" #n ")" ::: "memory")
#define PG8_WAIT_L(n) asm volatile("s_waitcnt lgkmcnt(" #n ")" ::: "memory")
#define PG8_BAR __builtin_amdgcn_s_barrier()
#define PG8_SCHED __builtin_amdgcn_sched_barrier(0)
    Unit cur, nxt; int ui = 0;
    if (!S.next(0, cur)) return;
    f32x4 acc[2][2][4][2];
#pragma unroll
    for (int a = 0; a < 2; ++a)
#pragma unroll
        for (int b = 0; b < 2; ++b)
#pragma unroll
            for (int m = 0; m < 4; ++m)
#pragma unroll
                for (int n = 0; n < 2; ++n) acc[a][b][m][n] = (f32x4){0.f, 0.f, 0.f, 0.f};
    bf16x8 At[4][2], B0[2][2], B1[2][2];
    unsigned va[2][2];
    if constexpr (GATHER) {
#pragma unroll
        for (int h = 0; h < 2; ++h)
#pragma unroll
            for (int i = 0; i < 2; ++i) va[h][i] = gtab[cur.slot * 256 + h * 128 + RA[i]] + voffA[i];
    }
    const char* cA = S.a_base(cur); const char* cB = S.b_base(cur);
    PG8_STAGE(PG8_SB(0, 0), cB, voffB); PG8_STAGE(PG8_SB(0, 1), cB + bhstep, voffB); PG8_STAGE_A(PG8_SA(0, 0), cA, 0, va); PG8_STAGE_A(PG8_SA(0, 1), cA, 1, va);
    if (wr == 1) PG8_BAR;
    PG8_WAIT_V(2); PG8_BAR;
    PG8_STAGE(PG8_SB(1, 0), cB + kstep, voffB); PG8_STAGE_A(PG8_SA(1, 0), cA + kstep, 0, va); PG8_STAGE(PG8_SB(1, 1), cB + bhstep + kstep, voffB);
    PG8_WAIT_V(6); PG8_BAR;
    for (;;) {
        const bool has_next = S.next(ui + 1, nxt);
        const char* nA = has_next ? S.a_base(nxt) : cA; const char* nB = has_next ? S.b_base(nxt) : cB;
#pragma clang loop unroll(disable)
        for (int t = 0; t < nt; t += 2) {
            const bool last = (t == nt - 2);
            const char* a1 = cA + (size_t)(t + 1) * kstep;
            const char* a2 = last ? nA : cA + (size_t)(t + 2) * kstep; const char* b2 = last ? nB : cB + (size_t)(t + 2) * kstep;
            const char* a3 = a2 + kstep; const char* b3 = b2 + kstep;
            if constexpr (MIDK) { if (t == nt / 2) E.midk(acc, cur, wr, fr); }
            PG8_LDB(B0, 0, 0); PG8_LDB(B1, 0, 1); PG8_SCHED; PG8_LDA(At, 0, 0); PG8_STAGE_A(PG8_SA(1, 1), a1, 1, va);
            if constexpr (GATHER) { if (last && has_next) {
#pragma unroll
                for (int h = 0; h < 2; ++h)
#pragma unroll
                    for (int i = 0; i < 2; ++i) va[h][i] = gtab[nxt.slot * 256 + h * 128 + RA[i]] + voffA[i]; } }
            PG8_WAIT_V(8); PG8_WAIT_L(0); PG8_BAR; PG8_MMA(0, 0, At, B0); PG8_MMA(0, 1, At, B1); PG8_BAR; PG8_SCHED;
            PG8_LDA(At, 0, 1); PG8_STAGE(PG8_SB(0, 0), b2, voffB); PG8_STAGE(PG8_SB(0, 1), b2 + bhstep, voffB); PG8_STAGE_A(PG8_SA(0, 0), a2, 0, va);
            PG8_WAIT_V(8); PG8_WAIT_L(0); PG8_BAR; PG8_MMA(1, 0, At, B0); PG8_MMA(1, 1, At, B1); PG8_BAR; PG8_SCHED;
            PG8_LDB(B0, 1, 0); PG8_LDB(B1, 1, 1); PG8_SCHED; PG8_LDA(At, 1, 0); PG8_STAGE_A(PG8_SA(0, 1), a2, 1, va);
            PG8_WAIT_V(8); PG8_WAIT_L(0); PG8_BAR; PG8_MMA(0, 0, At, B0); PG8_MMA(0, 1, At, B1); PG8_BAR; PG8_SCHED;
            PG8_LDA(At, 1, 1); PG8_STAGE(PG8_SB(1, 0), b3, voffB); PG8_STAGE(PG8_SB(1, 1), b3 + bhstep, voffB); PG8_STAGE_A(PG8_SA(1, 0), a3, 0, va);
            PG8_WAIT_V(8); PG8_WAIT_L(0); PG8_BAR; PG8_MMA(1, 0, At, B0); PG8_MMA(1, 1, At, B1); PG8_BAR; PG8_SCHED;
        }
        if (wr == 0) PG8_BAR;
        E(acc, cur, wr, wc, fr, fq);
        if (!has_next) break;
#pragma unroll
        for (int a = 0; a < 2; ++a)
#pragma unroll
            for (int b = 0; b < 2; ++b)
#pragma unroll
                for (int m = 0; m < 4; ++m)
#pragma unroll
                    for (int n = 0; n < 2; ++n) acc[a][b][m][n] = (f32x4){0.f, 0.f, 0.f, 0.f};
        cur = nxt; cA = nA; cB = nB; ++ui;
        if (wr == 1) PG8_BAR;
    }
    PG8_WAIT_V(0);
    PG8_BAR;
#undef PG8_SA
#undef PG8_SB
#undef PG8_STAGE
#undef PG8_STAGE_A
#undef PG8_LDA
#undef PG8_LDB
#undef PG8_MMA
#undef PG8_WAIT_V
#undef PG8_WAIT_L
#undef PG8_BAR
#undef PG8_SCHED
}

struct EpiInproj {
    static constexpr bool PERM = true;
    bf16* Z; LAS const f32x2* rt;
    DI void operator()(const f32x4 (&acc)[2][2][4][2], const Unit& u, int wr, int wc, int fr, int fq) const {
        const int row0 = u.pm * BM + wr * 64 + fr, col0 = u.pn * BM + wc * 64 + 8 * fq;
        const int kind = u.pn < 4 ? 0 : (u.pn == 4 ? 1 : (u.pn == 5 ? 2 : 3));
        const float sc = kind == 0 ? C2 : 1.f;
        const bool dorope = (kind <= 1) && ((wc & 1) == 0);
        float ch[8], cl[8]; const bool odd = (fq & 1) != 0;
        ch[0] = odd ? 2.250790858e-04f : 1.591549367e-01f; cl[0] = odd ? -6.755001072e-12f : 6.420638243e-09f;
        ch[1] = odd ? 9.911730740e-05f : 7.008652389e-02f; cl[1] = odd ? 1.969154007e-12f : -2.302696700e-09f;
        ch[2] = odd ? 4.364795313e-05f : 3.086376376e-02f; cl[2] = odd ? -3.416928741e-13f : -3.597993847e-10f;
        ch[3] = odd ? 1.922110096e-05f : 1.359137055e-02f; cl[3] = odd ? -2.712567042e-13f : 9.086624508e-11f;
        ch[4] = odd ? 8.464330676e-06f : 5.985185504e-03f; cl[4] = odd ? 1.318804142e-13f : 2.087540557e-10f;
        ch[5] = odd ? 3.727408512e-06f : 2.635675948e-03f; cl[5] = odd ? 9.029300745e-14f : -4.944578774e-11f;
        ch[6] = odd ? 1.641426252e-06f : 1.160663669e-03f; cl[6] = odd ? 1.098673646e-14f : -2.775752544e-11f;
        ch[7] = odd ? 7.228293271e-07f : 5.111175124e-04f; cl[7] = odd ? -2.017673985e-14f : -7.822671330e-12f;
#pragma unroll
        for (int ai = 0; ai < 2; ++ai)
#pragma unroll
            for (int m = 0; m < 4; ++m) { const int rl = ai * HALF + wr * 64 + m * 16 + fr; u32x4 wv[2];
                const f32x2 te = rt[u.slot * 256 + rl]; const float dq = te.x;
                f32x4 cs[2], sn[2];
                if (dorope) { const float p = te.y;
#pragma unroll
                    for (int n = 0; n < 2; ++n)
#pragma unroll
                        for (int j = 0; j < 4; ++j) { const int k = 4 * n + j; const float r = p * ch[k], e = __builtin_fmaf(p, ch[k], -r), x = __builtin_amdgcn_fractf(r) + __builtin_fmaf(p, cl[k], e);
                            cs[n][j] = __builtin_amdgcn_cosf(x); sn[n][j] = __builtin_amdgcn_sinf(x); }
                }
#pragma unroll
                for (int bj = 0; bj < 2; ++bj) { f32x4 v[2] = {acc[ai][bj][m][0], acc[ai][bj][m][1]};
                    if constexpr (INP_I8) { _Pragma("unroll") for (int n = 0; n < 2; ++n) { const v4i32 iv = __builtin_bit_cast(v4i32, v[n]); v[n] = (f32x4){(float)iv[0], (float)iv[1], (float)iv[2], (float)iv[3]} * dq; } }
                    if (kind == 3) {
#pragma unroll
                        for (int n = 0; n < 2; ++n) { f32x2 a = gelu_pk((f32x2){v[n][0], v[n][1]}), b = gelu_pk((f32x2){v[n][2], v[n][3]}); v[n] = (f32x4){a.x, a.y, b.x, b.y}; }
                    } else if (dorope && bj == 0) {
#pragma unroll
                        for (int n = 0; n < 2; ++n)
#pragma unroll
                            for (int j = 0; j < 4; ++j) { const float mine = v[n][j], other = xother32(mine);
                                v[n][j] = (fq < 2) ? (mine * cs[n][j] - other * sn[n][j]) : (mine * cs[n][j] + other * sn[n][j]); }
                    }
                    v[0] = v[0] * sc; v[1] = v[1] * sc;
                    wv[bj].x = cvt_pk_bf16(v[0][0], v[0][1]); wv[bj].y = cvt_pk_bf16(v[0][2], v[0][3]); wv[bj].z = cvt_pk_bf16(v[1][0], v[1][1]); wv[bj].w = cvt_pk_bf16(v[1][2], v[1][3]); }
                rows8_store(Z + (size_t)(u.pm * BM + rl - fr) * INW + col0, INW, fr, wv[0], wv[1]); }
    }
};
struct EpiOutproj {
    static constexpr bool PERM = true;
    bf16* MIX; LAS const f32x2* rr;
    DI void midk(f32x4 (&acc)[2][2][4][2], const Unit& u, int wr, int fr) const {
#pragma unroll
        for (int ai = 0; ai < 2; ++ai)
#pragma unroll
            for (int m = 0; m < 4; ++m) { const float s = rr[u.slot * 256 + ai * HALF + wr * 64 + m * 16 + fr].x;
#pragma unroll
                for (int bj = 0; bj < 2; ++bj)
#pragma unroll
                    for (int n = 0; n < 2; ++n) acc[ai][bj][m][n] = acc[ai][bj][m][n] * s; }
    }
    DI void operator()(const f32x4 (&acc)[2][2][4][2], const Unit& u, int wr, int wc, int fr, int fq) const {
        const int col0 = u.pn * BM + wc * 64 + 8 * fq;
#pragma unroll
        for (int ai = 0; ai < 2; ++ai)
#pragma unroll
            for (int m = 0; m < 4; ++m) { const int rl = ai * HALF + wr * 64 + m * 16 + fr; const float s = rr[u.slot * 256 + rl].y * (OUT_F8 ? 1.f / (W8_SCALE * YA_SCALE) : 1.f); u32x4 wv[2];
#pragma unroll
                for (int bj = 0; bj < 2; ++bj) { const f32x4 v0 = acc[ai][bj][m][0] * s, v1 = acc[ai][bj][m][1] * s;
                    wv[bj].x = cvt_pk_bf16(v0[0], v0[1]); wv[bj].y = cvt_pk_bf16(v0[2], v0[3]); wv[bj].z = cvt_pk_bf16(v1[0], v1[1]); wv[bj].w = cvt_pk_bf16(v1[2], v1[3]); }
                rows8_store(MIX + (size_t)(u.pm * BM + rl - fr) * D + col0, D, fr, wv[0], wv[1]); }
    }
};
struct EpiGateUp {
    static constexpr bool PERM = true;
    unsigned char* HID; LAS const float* wtab; LAS const int* tp;
    DI void operator()(const f32x4 (&acc)[2][2][4][2], const Unit& u, int wr, int wc, int fr, int fq) const {
        const int col0 = u.pn * HALF + wc * 32 + 8 * fq; const size_t rt = (size_t)(tp[u.e] + u.pm) * BM;
        constexpr float in_sc = MOE_FP8 ? 1.f / W8_SCALE : 1.f, out_sc = MOE_FP8 ? H8_SCALE : 1.f;
#pragma unroll
        for (int ai = 0; ai < 2; ++ai)
#pragma unroll
            for (int mp = 0; mp < 2; ++mp) { u32x2 pk8[2]; u32x4 pk16[2];
#pragma unroll
                for (int q = 0; q < 2; ++q) { const int m = 2 * mp + q; const int rl = ai * HALF + wr * 64 + m * 16 + fr; const float w = wtab[u.slot * 256 + rl] * out_sc; f32x4 o[2];
#pragma unroll
                    for (int n = 0; n < 2; ++n)
#pragma unroll
                        for (int j = 0; j < 4; ++j) { const float g = acc[ai][0][m][n][j] * in_sc, up = acc[ai][1][m][n][j] * in_sc; o[n][j] = g * __builtin_amdgcn_rcpf(1.f + __builtin_amdgcn_exp2f(-g * LOG2E)) * up * w; }
                    if constexpr (MOE_FP8) { pk8[q].x = pack4_fp8(o[0][0], o[0][1], o[0][2], o[0][3]); pk8[q].y = pack4_fp8(o[1][0], o[1][1], o[1][2], o[1][3]); }
                    else { pk16[q].x = cvt_pk_bf16(o[0][0], o[0][1]); pk16[q].y = cvt_pk_bf16(o[0][2], o[0][3]); pk16[q].z = cvt_pk_bf16(o[1][0], o[1][1]); pk16[q].w = cvt_pk_bf16(o[1][2], o[1][3]); } }
                const int rl0 = ai * HALF + wr * 64 + (2 * mp) * 16 + fr;
                if constexpr (MOE_FP8) {
                    const u32x4 w16 = pair16(pk8[0], pk8[1]); const int odd = fq & 1;
                    *(u32x4*)(HID + (rt + rl0 + 16 * odd) * FF + col0 - 8 * odd) = w16; }
                else { *(u32x4*)((bf16*)HID + (rt + rl0) * FF + col0) = pk16[0]; *(u32x4*)((bf16*)HID + (rt + rl0 + 16) * FF + col0) = pk16[1]; } }
    }
};
struct EpiDown {
    static constexpr bool PERM = true;
    unsigned char* YK; LAS const unsigned* dtab;
    DI void operator()(const f32x4 (&acc)[2][2][4][2], const Unit& u, int wr, int wc, int fr, int fq) const {
        const int col0 = u.pn * BM + wc * 64 + 8 * fq; constexpr float sc = (MOE_FP8 ? 1.f / (W8_SCALE * H8_SCALE) : 1.f) * (YK_FP8 ? Y8_SCALE : 1.f);
#pragma unroll
        for (int ai = 0; ai < 2; ++ai)
#pragma unroll
            for (int m = 0; m < 4; ++m) { const int rl = ai * HALF + wr * 64 + m * 16 + fr; const unsigned dst = dtab[u.slot * 256 + rl];
                if constexpr (YK_FP8) { u32x2 w[2];
#pragma unroll
                    for (int bj = 0; bj < 2; ++bj) { const f32x4 v0 = acc[ai][bj][m][0] * sc, v1 = acc[ai][bj][m][1] * sc; w[bj].x = pack4_fp8(v0[0], v0[1], v0[2], v0[3]); w[bj].y = pack4_fp8(v1[0], v1[1], v1[2], v1[3]); }
                    const u32x4 w16 = pair16(w[0], w[1]); const int odd = fq & 1;
                    if (dst != 0xffffffffu) *(u32x4*)(YK + (size_t)dst * D + col0 - 8 * odd + 32 * odd) = w16;
                } else { if (dst != 0xffffffffu) {
#pragma unroll
                    for (int bj = 0; bj < 2; ++bj) { const f32x4 v0 = acc[ai][bj][m][0] * sc, v1 = acc[ai][bj][m][1] * sc;
                        u32x4 w; w.x = cvt_pk_bf16(v0[0], v0[1]); w.y = cvt_pk_bf16(v0[2], v0[3]); w.z = cvt_pk_bf16(v1[0], v1[1]); w.w = cvt_pk_bf16(v1[2], v1[3]);
                        *(u32x4*)((bf16*)YK + (size_t)dst * D + col0 + bj * 32) = w; } } } }
    }
};
}

#define XB_TMO      128
#define XB_XCNT(j)  (256  + 64 * (j))
#define XB_XSUB(j)  (1280 + 64 * (j))
#define XB_XGEN(j)  (2304 + 64 * (j))
#define XB_TOP      3328
#define XB_TOPGEN   3392
#define XCD_BAR_WORDS 3456
#define XB_SPIN_CAP (1u << 18)
DI unsigned xb_ld(unsigned* p)              { return __hip_atomic_load(p, __ATOMIC_RELAXED, __HIP_MEMORY_SCOPE_AGENT); }
DI unsigned xb_add(unsigned* p, unsigned v) { return __hip_atomic_fetch_add(p, v, __ATOMIC_RELAXED, __HIP_MEMORY_SCOPE_AGENT); }
DI unsigned xb_xcc_id() { return (unsigned)__builtin_amdgcn_s_getreg((3 << 11) | 20) & 0xFu; }
#define XB_SPIN(cond, bar) do { unsigned _sp = 0; while (cond) { __builtin_amdgcn_s_sleep(1); \
    if ((++_sp & 255u) == 0u) { if (xb_ld(&(bar)[XB_TMO])) break; if (_sp > XB_SPIN_CAP) { atomicAdd(&(bar)[XB_TMO], 1u); break; } } } } while (0)
struct XcdBarrier { unsigned* bar; unsigned x; volatile LAS unsigned* st; };
DI XcdBarrier xcd_barrier_post(unsigned* bar, volatile LAS unsigned* st) {
    XcdBarrier b; b.bar = bar; b.x = xb_xcc_id(); b.st = st;
    if (threadIdx.x == 0) (void)xb_add(&bar[XB_XCNT(b.x)], 1u);
    return b;
}
DI void xcd_barrier_complete(unsigned* bar, unsigned x, unsigned& nloc, unsigned& nx) {
    const unsigned G = gridDim.x * gridDim.y * gridDim.z;
    unsigned sum, cnt, mine, sp = 0u;
    for (;;) {
        sum = 0u; cnt = 0u; mine = 0u;
#pragma unroll
        for (unsigned j = 0; j < 16; ++j) { const unsigned c = xb_ld(&bar[XB_XCNT(j)]); sum += c; cnt += (c > 0u) ? 1u : 0u; mine = (j == x) ? c : mine; }
        if (sum == G) break;
        __builtin_amdgcn_s_sleep(1);
        if ((++sp & 255u) == 0u) { if (xb_ld(&bar[XB_TMO])) break; if (sp > XB_SPIN_CAP) { atomicAdd(&bar[XB_TMO], 1u); break; } }
    }
    nloc = mine > 0u ? mine : 1u; nx = cnt > 0u ? cnt : 1u;
}
DI void xcd_barrier(const XcdBarrier& b) {
    asm volatile("s_waitcnt vmcnt(0)" ::: "memory");
    __syncthreads();
    if (threadIdx.x == 0) {
        unsigned* bar = b.bar;
        __builtin_amdgcn_s_waitcnt(0);
        unsigned nloc = b.st[0], nx = b.st[1];
        if (nloc == 0u) { xcd_barrier_complete(bar, b.x, nloc, nx); b.st[0] = nloc; b.st[1] = nx; }
        const unsigned old = xb_add(&bar[XB_XSUB(b.x)], 1u);
        const unsigned gen = old / nloc;
        if (old + 1u == (gen + 1u) * nloc) {
            __builtin_amdgcn_fence(__ATOMIC_RELEASE, "agent");
            asm volatile("s_waitcnt vmcnt(0)" ::: "memory");
            const unsigned og = xb_add(&bar[XB_TOP], 1u);
            const unsigned tg = og / nx;
            if (og + 1u == (tg + 1u) * nx) xb_add(&bar[XB_TOPGEN], 1u);
            else XB_SPIN(xb_ld(&bar[XB_TOPGEN]) == tg, bar);
            __builtin_amdgcn_fence(__ATOMIC_ACQUIRE, "agent");
            xb_add(&bar[XB_XGEN(b.x)], 1u);
            asm volatile("s_waitcnt vmcnt(0)" ::: "memory");
        } else {
            XB_SPIN(xb_ld(&bar[XB_XGEN(b.x)]) == gen, bar);
            __builtin_amdgcn_fence(__ATOMIC_ACQUIRE, "agent");
            asm volatile("s_waitcnt vmcnt(0)" ::: "memory");
        }
    }
    __syncthreads();
}

constexpr int NWAVES = 8;
constexpr int RING_BYTES = 131072;
constexpr int TAB_OFF = RING_BYTES;
constexpr int TAB_BYTES = 14336;
constexpr int MISC_OFF = TAB_OFF + TAB_BYTES;
constexpr int LDS_BYTES = 147456;
static_assert(MISC_OFF + 256 <= LDS_BYTES, "LDS map");
constexpr int MAX_SLOTS = 7;

struct Frame { LAS unsigned char* lds; volatile LAS unsigned* MISC; gu32* ctl; int tid, lane, wave, G, gw, NGW; };
struct Ptrs {
    const float *x, *c, *w_ada, *b_ada, *g_mix_pre, *g_mix_post, *w_in, *sink, *gn, *wsp, *bsp, *gg, *w_out, *g_ffn_pre, *g_ffn_post, *w_rg, *b_rg, *w_re, *b_re, *w_gate, *w_up, *w_down;
    const int* pos; float* out;
    float *mod, *rope, *ssp, *lw, *wrgT, *wreT, *asc; unsigned* list; unsigned* ctlcnt; unsigned* wmaxw; bf16 *MIX, *HB, *wsb, *WinT, *WoT, *WguT, *WdT, *A, *Z, *Y, *HID, *YK;
};
constexpr int I_IN = 32 * 112, I_OUT = 32 * 64, I_E = 1024, NITEMS = I_IN + I_OUT + 3 * NE * I_E;
#ifndef CONV_ITEMS
#define CONV_ITEMS 12288
#endif
constexpr int I_DOWN0 = I_IN + I_OUT + 2 * NE * I_E;
constexpr int P0_SPLIT = I_DOWN0 - CONV_ITEMS;
DI int conv_wgs(int G) { return (G == 256) ? 32 : 0; }
DI int conv_split(int G) { return conv_wgs(G) ? P0_SPLIT : NITEMS; }
struct ItemDesc { const float* W; bf16* WT; const float* kscale; int K, N, k0, n0, out_row0, f8; float qs; };
DI ItemDesc decode_item(const Ptrs& P, int it) {
    ItemDesc d; int r = it; d.kscale = nullptr; d.f8 = 0; d.qs = 1.f;
    if (r < I_IN) { d.W = P.w_in; d.WT = P.WinT; d.K = D; d.N = INW; d.k0 = 64 * (r / 112); d.n0 = 32 * (r % 112); d.out_row0 = d.n0;
        if (INP_I8) { d.f8 = 2; d.qs = 127.f / fmaxf(__uint_as_float(__hip_atomic_load(P.wmaxw, RLX_AGENT)), 1e-30f); } return d; } r -= I_IN;
    if (r < I_OUT) { d.W = P.w_out; d.WT = P.WoT; d.K = D; d.N = D; d.k0 = 64 * (r / 64); d.n0 = 32 * (r % 64); d.out_row0 = d.n0; d.kscale = P.gg; if (OUT_F8) d.f8 = 1; return d; } r -= I_OUT;
    const int which = r / (NE * I_E); r -= which * NE * I_E; const int e = r / I_E; r -= e * I_E; d.f8 = MOE_FP8;
    if (which < 2) { d.W = (which ? P.w_up : P.w_gate) + (size_t)e * D * FF; d.WT = P.WguT + (size_t)e * 2048 * (MOE_FP8 ? 1024 : 2048); d.K = D; d.N = FF; d.k0 = 64 * (r / 32); d.n0 = 32 * (r % 32); d.out_row0 = (d.n0 >> 7) * 256 + ((d.n0 >> 5) & 3) * 64 + which * 32; }
    else { d.W = P.w_down + (size_t)e * FF * D; d.WT = P.WdT + (size_t)e * 2048 * (MOE_FP8 ? 512 : 1024); d.K = FF; d.N = D; d.k0 = 64 * (r / 64); d.n0 = 32 * (r % 64); d.out_row0 = d.n0; }
    return d;
}
DI void item_load(const ItemDesc& d, f32x4 (&v)[8], int lane) {
    const float* p = d.W + (size_t)(d.k0 + (lane >> 3)) * d.N + d.n0 + 4 * (lane & 7);
#pragma unroll
    for (int i = 0; i < 8; ++i) v[i] = __builtin_nontemporal_load((const GAS f32x4*)(p + (size_t)(8 * i) * d.N));
}
DI void item_finish(const ItemDesc& d, const f32x4 (&v)[8], LAS float* scr, int lane) {
    const int kr = lane >> 3, q = lane & 7;
#pragma unroll
    for (int i = 0; i < 8; ++i) { f32x4 x = v[i]; if (d.kscale) x = x * d.kscale[d.k0 + 8 * i + kr]; LAS float* w = scr + (8 * i + kr) * 33 + 4 * q; w[0] = x.x; w[1] = x.y; w[2] = x.z; w[3] = x.w; }
    LDS_WAIT(); asm volatile("" ::: "memory");
    const int c = lane & 7;
    if (d.f8 == 2) {
#pragma unroll
        for (int j = 0; j < 4; ++j) { const int n = (lane >> 3) + 8 * j; const LAS float* s = scr + (8 * c) * 33 + n; const float q = d.qs;
            u32x2 o; o.x = pack4_i8(clamp127(s[0 * 33] * q), clamp127(s[1 * 33] * q), clamp127(s[2 * 33] * q), clamp127(s[3 * 33] * q)); o.y = pack4_i8(clamp127(s[4 * 33] * q), clamp127(s[5 * 33] * q), clamp127(s[6 * 33] * q), clamp127(s[7 * 33] * q));
            *(GAS u32x2*)((unsigned char*)d.WT + (size_t)(d.out_row0 + n) * d.K + d.k0 + 8 * c) = o; }
    } else if (d.f8) {
#pragma unroll
        for (int j = 0; j < 4; ++j) { const int n = (lane >> 3) + 8 * j; const LAS float* s = scr + (8 * c) * 33 + n;
            u32x2 o; o.x = pack4_fp8(s[0 * 33] * W8_SCALE, s[1 * 33] * W8_SCALE, s[2 * 33] * W8_SCALE, s[3 * 33] * W8_SCALE); o.y = pack4_fp8(s[4 * 33] * W8_SCALE, s[5 * 33] * W8_SCALE, s[6 * 33] * W8_SCALE, s[7 * 33] * W8_SCALE);
            __builtin_nontemporal_store(o, (GAS u32x2*)((unsigned char*)d.WT + (size_t)(d.out_row0 + n) * d.K + d.k0 + 8 * c)); }
    } else {
#pragma unroll
        for (int j = 0; j < 4; ++j) { const int n = (lane >> 3) + 8 * j; const LAS float* s = scr + (8 * c) * 33 + n;
            u32x4 o; o.x = cvtpk_s(s[0 * 33], s[1 * 33]); o.y = cvtpk_s(s[2 * 33], s[3 * 33]); o.z = cvtpk_s(s[4 * 33], s[5 * 33]); o.w = cvtpk_s(s[6 * 33], s[7 * 33]);
            *(GAS u32x4*)(d.WT + (size_t)(d.out_row0 + n) * d.K + d.k0 + 8 * c) = o; }
    }
    LDS_WAIT(); asm volatile("" ::: "memory");
}
#ifndef CONV_DEPTH
#define CONV_DEPTH 2
#endif
DI void convert_range(const Ptrs& P, int first, int end, int stride, LAS float* scr, int lane) {
    constexpr int DEPTH = CONV_DEPTH; f32x4 buf[DEPTH][8]; ItemDesc dsc[DEPTH];
#pragma unroll
    for (int q = 0; q < DEPTH - 1; ++q) { const int it = first + q * stride; dsc[q] = decode_item(P, it < end ? it : first); if (it < end) item_load(dsc[q], buf[q], lane); }
    for (int base = first; base < end; base += DEPTH * stride) {
#pragma unroll
        for (int q = 0; q < DEPTH; ++q) {
            const int it = base + q * stride; if (it >= end) return;
            const int pf = it + (DEPTH - 1) * stride; constexpr int dummy = 0; (void)dummy;
            if (pf < end) { dsc[(q + DEPTH - 1) % DEPTH] = decode_item(P, pf); item_load(dsc[(q + DEPTH - 1) % DEPTH], buf[(q + DEPTH - 1) % DEPTH], lane); }
            item_finish(dsc[q], buf[q], scr, lane);
        }
    }
}
DI float modv(const Ptrs& P, int b, int idx) { const float* m = P.mod + b * MODW + idx; return ((m[0] + m[NB * MODW]) + (m[2 * NB * MODW] + m[3 * NB * MODW])) + P.b_ada[idx]; }
DI void p0_prologue(Frame& F, const Ptrs& P) {
    LAS float* ca = (LAS float*)F.lds; LAS float* PP = (LAS float*)(F.lds + 65536);
    const int kg = F.tid >> 4, c4 = F.tid & 15; constexpr int NITM = 4 * (MODW / 64), NSCAN = D * INW / 4;
    const int gt = F.gw * 64 + F.lane, NGT = F.NGW * 64;
    f32x4 cv[8];
#pragma unroll
    for (int j = 0; j < 8; ++j) cv[j] = *(const GAS f32x4*)(P.c + 4 * (F.tid + NWAVES * 64 * j));
#define P0_LOADW(W_, ITEM_) do { const int chunk_ = (ITEM_) % (MODW / 64), kq_ = (ITEM_) / (MODW / 64); const float* wp_ = P.w_ada + (size_t)(512 * kq_ + kg) * MODW + 64 * chunk_ + 4 * c4; \
        _Pragma("unroll") for (int i = 0; i < 16; ++i) W_[i] = __builtin_nontemporal_load((const GAS f32x4*)(wp_ + (size_t)(32 * i) * MODW)); } while (0)
    int item = blockIdx.x; f32x4 w[16];
    if (item < NITM) P0_LOADW(w, item);
    float t_rg = 0.f, t_re = 0.f, t_sb = 0.f;
    if (gt < NG * D) t_rg = P.w_rg[(gt % D) * NG + gt / D];
    if (gt < NE * D) t_re = P.w_re[(gt % D) * NE + gt / D];
    if (gt < GH * CH * CH) t_sb = P.wsp[gt];
    const GAS f32x4* wsc = (const GAS f32x4*)P.w_in; int sbase = gt; f32x4 sv[7]; bool spend = false; float wm = 0.f;
#define P0_SCAN_ISSUE() do { _Pragma("unroll") for (int j = 0; j < 7; ++j) { const int idx_ = sbase + j * NGT; sv[j] = (INP_I8 && idx_ < NSCAN) ? wsc[idx_] : (f32x4){0.f, 0.f, 0.f, 0.f}; } sbase += 7 * NGT; spend = true; } while (0)
#define P0_SCAN_EAT() do { _Pragma("unroll") for (int j = 0; j < 7; ++j) wm = fmaxf(wm, fmaxf(fmaxf(fabsf(sv[j].x), fabsf(sv[j].y)), fmaxf(fabsf(sv[j].z), fabsf(sv[j].w)))); spend = false; } while (0)
    if (INP_I8 && sbase < NSCAN) P0_SCAN_ISSUE();
    asm volatile("" ::: "memory");
#pragma unroll
    for (int j = 0; j < 8; ++j) { f32x4 o; o.x = cv[j].x / (1.f + expf(-cv[j].x)); o.y = cv[j].y / (1.f + expf(-cv[j].y)); o.z = cv[j].z / (1.f + expf(-cv[j].z)); o.w = cv[j].w / (1.f + expf(-cv[j].w)); *(LAS f32x4*)(ca + 4 * (F.tid + NWAVES * 64 * j)) = o; }
    __syncthreads();
    while (item < NITM) {
        const int nitem = item + F.G; const bool has = nitem < NITM; f32x4 wn[16];
        if (has) P0_LOADW(wn, nitem);
        asm volatile("" ::: "memory");
        const int chunk = item % (MODW / 64), kq = item / (MODW / 64), kbase = 512 * kq;
        f32x4 acc[NB];
#pragma unroll
        for (int b = 0; b < NB; ++b) acc[b] = (f32x4){0.f, 0.f, 0.f, 0.f};
#pragma unroll
        for (int i = 0; i < 16; ++i) { const int k = kbase + kg + 32 * i;
#pragma unroll
            for (int b = 0; b < NB; ++b) acc[b] += w[i] * ca[b * D + k]; }
#pragma unroll
        for (int b = 0; b < NB; ++b) *(LAS f32x4*)(PP + (kg * 8 + b) * 64 + 4 * c4) = acc[b];
        __syncthreads();
        { const int b = F.tid >> 6, col = F.tid & 63; float sacc = 0.f;
#pragma unroll 8
          for (int k2 = 0; k2 < 32; ++k2) sacc += PP[(k2 * 8 + b) * 64 + col];
          P.mod[(size_t)kq * NB * MODW + b * MODW + 64 * chunk + col] = sacc; }
        __syncthreads();
        if (spend) { P0_SCAN_EAT(); if (sbase < NSCAN) P0_SCAN_ISSUE(); }
        asm volatile("" ::: "memory");
        if (has) {
#pragma unroll
            for (int i = 0; i < 16; ++i) w[i] = wn[i]; }
        item = nitem;
    }
    while (spend) { P0_SCAN_EAT(); if (sbase < NSCAN) P0_SCAN_ISSUE(); }
#undef P0_LOADW
#undef P0_SCAN_ISSUE
#undef P0_SCAN_EAT
    if constexpr (INP_I8) {
#pragma unroll
        for (int o = 1; o < 64; o <<= 1) wm = fmaxf(wm, __shfl_xor(wm, o));
        if (F.lane == 0) atomicMax(P.wmaxw, __float_as_uint(wm)); }
    if (gt < NG * D) P.wrgT[gt] = t_rg;
    if (gt < NE * D) P.wreT[gt] = t_re;
    if (gt < GH * CH * CH) P.wsb[gt] = f2bf(t_sb);
    for (int i = gt + NGT; i < NG * D; i += NGT) { const int g = i / D, k = i % D; P.wrgT[i] = P.w_rg[k * NG + g]; }
    for (int i = gt + NGT; i < NE * D; i += NGT) { const int ge = i / D, k = i % D; P.wreT[i] = P.w_re[k * NE + ge]; }
    for (int i = gt + NGT; i < GH * CH * CH; i += NGT) P.wsb[i] = f2bf(P.wsp[i]);
}
DI void p1_norm(Frame& F, const Ptrs& P) {
    LAS float* G1 = (LAS float*)F.lds; LAS float* H1 = G1 + D; constexpr int RPB = 64; const int lane = F.lane;
    for (int blk = blockIdx.x; blk < T / RPB; blk += F.G) {
        const int row_base = blk * RPB, b = row_base / S;
        f32x4 cur[8];
        { const GAS f32x4* xr = (const GAS f32x4*)(P.x + (size_t)(row_base + F.wave) * D) + lane;
#pragma unroll
          for (int j = 0; j < 8; ++j) cur[j] = __builtin_nontemporal_load(xr + 64 * j); }
        __syncthreads();
        for (int i = F.tid; i < D; i += NWAVES * 64) { G1[i] = P.g_mix_pre[i] * (1.f + modv(P, b, D + i)); H1[i] = modv(P, b, i); }
        __syncthreads();
        for (int rr = F.wave; rr < RPB; rr += NWAVES) {
            const int row = row_base + rr; f32x4 nxt[8];
            if (rr + NWAVES < RPB) { const GAS f32x4* xr = (const GAS f32x4*)(P.x + (size_t)(row + NWAVES) * D) + lane;
#pragma unroll
                for (int j = 0; j < 8; ++j) nxt[j] = __builtin_nontemporal_load(xr + 64 * j); }
            float ss = 0.f;
#pragma unroll
            for (int j = 0; j < 8; ++j) ss += (cur[j].x * cur[j].x + cur[j].y * cur[j].y) + (cur[j].z * cur[j].z + cur[j].w * cur[j].w);
            const float r = rsqrtf(wave_sum(ss) * (1.f / D) + EPS);
            if constexpr (INP_I8) {
                f32x4 av[8]; float amax = 1e-30f;
#pragma unroll
                for (int j = 0; j < 8; ++j) { const int col = 4 * lane + 256 * j; const f32x4 g = *(const LAS f32x4*)(G1 + col), sh = *(const LAS f32x4*)(H1 + col);
                    av[j] = cur[j] * r * g + sh; amax = fmaxf(amax, fmaxf(fmaxf(fabsf(av[j].x), fabsf(av[j].y)), fmaxf(fabsf(av[j].z), fabsf(av[j].w)))); }
#pragma unroll
                for (int o = 1; o < 64; o <<= 1) amax = fmaxf(amax, __shfl_xor(amax, o));
                const float qs = 127.f / amax; if (lane == 0) P.asc[row] = amax * (1.f / 127.f);
                GAS unsigned* o4 = (GAS unsigned*)((unsigned char*)P.A + (size_t)row * D) + lane;
#pragma unroll
                for (int j = 0; j < 8; ++j) o4[64 * j] = pack4_i8(av[j].x * qs, av[j].y * qs, av[j].z * qs, av[j].w * qs);
            } else {
            GAS u32x2* o8 = (GAS u32x2*)(P.A + (size_t)row * D) + lane;
#pragma unroll
            for (int j = 0; j < 8; ++j) { const int col = 4 * lane + 256 * j; const f32x4 g = *(const LAS f32x4*)(G1 + col), sh = *(const LAS f32x4*)(H1 + col);
                const f32x4 a = cur[j] * r * g + sh; u32x2 w; w.x = cvt_pk_bf16(a.x, a.y); w.y = cvt_pk_bf16(a.z, a.w); o8[64 * j] = w; }
            }
#pragma unroll
            for (int j = 0; j < 8; ++j) cur[j] = nxt[j];
        }
    }
    __syncthreads();
    { LAS float* scr = (LAS float*)(F.lds + F.wave * 16384); convert_range(P, F.gw, conv_split(F.G), F.NGW, scr, F.lane); }
}
DI int crow(int r, int hi) { return (r & 3) + 8 * (r >> 2) + 4 * hi; }
#define KSWZ(row, colB) ((row) * 256 + ((colB) ^ (((row) & 7) << 4)))
DI int vimg_off(int row, int ch) { return 2048 * (row >> 3) + 512 * (ch >> 2) + 64 * (row & 7) + 16 * ((ch & 3) ^ ((row >> 2) & 3)); }
DI s16x4 vtr(LAS const unsigned char* p) { return __builtin_bit_cast(s16x4, __builtin_amdgcn_ds_read_tr16_b64_v4i16((LAS v4i16_t*)p)); }
DI bf16x8 pack8(const f32x16& x, int s) {
    u32x4 p; p.x = cvtpk_s(x[8 * s + 0], x[8 * s + 1]); p.y = cvtpk_s(x[8 * s + 2], x[8 * s + 3]); p.z = cvtpk_s(x[8 * s + 4], x[8 * s + 5]); p.w = cvtpk_s(x[8 * s + 6], x[8 * s + 7]);
    return __builtin_bit_cast(bf16x8, p);
}
#define MFMA32(a, b, c) __builtin_amdgcn_mfma_f32_32x32x16_bf16((a), (b), (c), 0, 0, 0)
DI void attn_unit(Frame& F, const Ptrs& P, int b, int kvh, int pb) {
    const int tid = F.tid, lane = F.lane, w = F.wave, r32 = lane & 31, h = lane >> 5;
    const int hq = kvh * 4 + (w >> 1), p0 = pb * 64, qpos = p0 + 32 * (w & 1) + r32; const size_t trow = (size_t)b * S + qpos;
    LAS unsigned char* Kb = F.lds; LAS unsigned char* Vb = F.lds + 32768;
    bf16x8 qr[8]; { const bf16* qp = P.Z + trow * INW + OQ + hq * HD + 8 * h;
#pragma unroll
        for (int d0 = 0; d0 < 8; ++d0) qr[d0] = *(const bf16x8*)(qp + 16 * d0); }
    f32x16 o[4];
#pragma unroll
    for (int d0 = 0; d0 < 4; ++d0)
#pragma unroll
        for (int r = 0; r < 16; ++r) o[d0][r] = 0.f;
    float m_run = P.sink[hq] * LOG2E, l_run = 1.f;
    const int j_lo = p0 >= 128 ? 0 : (128 - p0) / 64, j_hi = (S - 64 - p0 + 128) / 64 < 4 ? (S - 64 - p0 + 128) / 64 : 4;
    const int sr = tid >> 4, sc = tid & 15;
    const bf16* kg = P.Z + ((size_t)b * S) * INW + OK_ + kvh * HD + sc * 8; const bf16* vg = P.Z + ((size_t)b * S) * INW + OV + kvh * HD + sc * 8;
    const int kst0 = KSWZ(sr, sc * 16), kst1 = KSWZ(sr + 32, sc * 16), vst0 = vimg_off(sr, sc), vst1 = vimg_off(sr + 32, sc);
    const int q4 = (lane & 15) >> 2, p4 = lane & 3, g16 = (lane >> 4) & 1;
    const int vb0 = 64 * (4 * h + q4) + 16 * ((2 * g16 + (p4 >> 1)) ^ h) + 8 * (p4 & 1), vb1 = 2048 + 64 * (4 * h + q4) + 16 * ((2 * g16 + (p4 >> 1)) ^ (h + 2)) + 8 * (p4 & 1);
    bf16x8 sk0, sk1, sv0, sv1;
#define ATT_LOAD(j) do { const size_t r0 = (size_t)(p0 - 128 + 64 * (j) + sr) * INW; sk0 = *(const bf16x8*)(kg + r0); sk1 = *(const bf16x8*)(kg + r0 + (size_t)32 * INW); sv0 = *(const bf16x8*)(vg + r0); sv1 = *(const bf16x8*)(vg + r0 + (size_t)32 * INW); } while (0)
#define ATT_WRITE(bi) do { *(LAS bf16x8*)(Kb + (bi) * 16384 + kst0) = sk0; *(LAS bf16x8*)(Kb + (bi) * 16384 + kst1) = sk1; *(LAS bf16x8*)(Vb + (bi) * 16384 + vst0) = sv0; *(LAS bf16x8*)(Vb + (bi) * 16384 + vst1) = sv1; } while (0)
    ATT_LOAD(j_lo); ATT_WRITE(0);
    __syncthreads();
    for (int j = j_lo; j <= j_hi; ++j) {
        const int cur = (j - j_lo) & 1;
        if (j < j_hi) ATT_LOAD(j + 1);
        LAS const unsigned char* Kc = Kb + cur * 16384; LAS const unsigned char* Vc = Vb + cur * 16384;
        f32x16 s0, s1;
#pragma unroll
        for (int r = 0; r < 16; ++r) { s0[r] = 0.f; s1[r] = 0.f; }
#pragma unroll
        for (int d0 = 0; d0 < 8; ++d0) { const bf16x8 a0 = *(const LAS bf16x8*)(Kc + KSWZ(r32, (d0 * 16 + h * 8) * 2)); s0 = MFMA32(a0, qr[d0], s0); }
#pragma unroll
        for (int d0 = 0; d0 < 8; ++d0) { const bf16x8 a1 = *(const LAS bf16x8*)(Kc + KSWZ(32 + r32, (d0 * 16 + h * 8) * 2)); s1 = MFMA32(a1, qr[d0], s1); }
        if (j == 0 || j == 4) { const int kbase = p0 - 128 + 64 * j - qpos;
#pragma unroll
            for (int r = 0; r < 16; ++r) { const int d0 = kbase + crow(r, h), d1 = d0 + 32; if (d0 < -WIN || d0 > WIN) s0[r] = -1e30f; if (d1 < -WIN || d1 > WIN) s1[r] = -1e30f; } }
        float pmax = s0[0];
#pragma unroll
        for (int r = 1; r < 16; ++r) pmax = fmaxf(pmax, s0[r]);
#pragma unroll
        for (int r = 0; r < 16; ++r) pmax = fmaxf(pmax, s1[r]);
        pmax = xmax32(pmax);
        pmax -= m_run;
        float dlt = 0.f;
        if (__any(pmax > 8.f)) { dlt = fmaxf(pmax, 0.f); const float alpha = __builtin_amdgcn_exp2f(-dlt); l_run *= alpha;
#pragma unroll
            for (int d0 = 0; d0 < 4; ++d0)
#pragma unroll
                for (int r = 0; r < 16; ++r) o[d0][r] *= alpha; }
        const float mn = m_run + dlt; m_run = mn;
        float ps = 0.f;
#pragma unroll
        for (int r = 0; r < 16; ++r) { s0[r] = __builtin_amdgcn_exp2f(s0[r] - mn); s1[r] = __builtin_amdgcn_exp2f(s1[r] - mn); ps += s0[r] + s1[r]; }
        ps = xsum32(ps); l_run += ps;
        const bf16x8 pb0 = pack8(s0, 0), pb1 = pack8(s0, 1), pb2 = pack8(s1, 0), pb3 = pack8(s1, 1);
#pragma unroll
        for (int d0 = 0; d0 < 4; ++d0) {
#define ATT_VF(ks) ({ const s16x4 lo_ = vtr(Vc + vb0 + 4096 * (ks) + 512 * d0), hi_ = vtr(Vc + vb1 + 4096 * (ks) + 512 * d0); (bf16x8){lo_[0], lo_[1], lo_[2], lo_[3], hi_[0], hi_[1], hi_[2], hi_[3]}; })
            const bf16x8 v0 = ATT_VF(0), v1 = ATT_VF(1), v2 = ATT_VF(2), v3 = ATT_VF(3);
            o[d0] = MFMA32(v0, pb0, o[d0]); o[d0] = MFMA32(v1, pb1, o[d0]); o[d0] = MFMA32(v2, pb2, o[d0]); o[d0] = MFMA32(v3, pb3, o[d0]);
        }
        if (j < j_hi) ATT_WRITE(cur ^ 1);
        __syncthreads();
    }
    const float inv = 1.f / l_run; float ss = 0.f; bf16* yp = P.Y + trow * D + hq * HD + 4 * h;
#pragma unroll
    for (int d0 = 0; d0 < 4; ++d0)
#pragma unroll
        for (int g4 = 0; g4 < 4; ++g4) { const float a = o[d0][4 * g4] * inv, b2 = o[d0][4 * g4 + 1] * inv, c = o[d0][4 * g4 + 2] * inv, d = o[d0][4 * g4 + 3] * inv; ss += (a * a + b2 * b2) + (c * c + d * d);
            if constexpr (OUT_F8) { *(unsigned*)((unsigned char*)P.Y + trow * D + hq * HD + 4 * h + 32 * d0 + 8 * g4) = pack4_fp8(a * YA_SCALE, b2 * YA_SCALE, c * YA_SCALE, d * YA_SCALE); } else { u32x2 wv; wv.x = cvt_pk_bf16(a, b2); wv.y = cvt_pk_bf16(c, d); *(u32x2*)(yp + 32 * d0 + 8 * g4) = wv; } }
    ss = xsum32(ss); if (h == 0) P.ssp[trow * SSPW + hq] = ss;
#undef ATT_LOAD
#undef ATT_WRITE
}
DI void gmlp_phase(Frame& F, const Ptrs& P) {
    constexpr int NGM = NB * (S / CH) * GH;
    const int tid = F.tid, lane = F.lane, w = F.wave, r32 = lane & 31, h = lane >> 5, ch = tid & 15;
    LAS unsigned char* VC = F.lds;
    const int q4 = (lane & 15) >> 2, p4 = lane & 3, g16 = (lane >> 4) & 1;
    const int vb0 = 64 * (4 * h + q4) + 16 * ((2 * g16 + (p4 >> 1)) ^ h) + 8 * (p4 & 1), vb1 = 2048 + 64 * (4 * h + q4) + 16 * ((2 * g16 + (p4 >> 1)) ^ (h + 2)) + 8 * (p4 & 1);
    const int p = 32 * (w & 3) + r32, dp = w >> 2;
    int u = blockIdx.x; if (u >= NGM) return;
    bf16x8 raw[4];
#define GM_DECODE(uu, hh_, t0_) const int hh_ = (uu) % GH; const size_t t0_ = (size_t)((uu) / (GH * (S / CH))) * S + (size_t)(((uu) / GH) % (S / CH)) * CH
#define GM_LOADV(hh_, t0_) do { _Pragma("unroll") for (int i = 0; i < 4; ++i) raw[i] = *(const bf16x8*)(P.Z + ((t0_) + (tid >> 4) + 32 * i) * INW + OVG + (hh_) * HD + 8 * ch); } while (0)
    { GM_DECODE(u, hh0, t00); GM_LOADV(hh0, t00); }
    for (;;) {
        GM_DECODE(u, hh, t0);
        const size_t trow = t0 + p;
        s16x4 uv[2][4]; { const bf16* up = P.Z + trow * INW + OU + hh * HD + 4 * h;
#pragma unroll
            for (int dd = 0; dd < 2; ++dd)
#pragma unroll
                for (int g4 = 0; g4 < 4; ++g4) uv[dd][g4] = *(const s16x4*)(up + 32 * (2 * dp + dd) + 8 * g4); }
        const float bias = P.bsp[hh * CH + p];
        const f32x4 g0 = *(const f32x4*)(P.gn + hh * HD + 8 * ch), g1 = *(const f32x4*)(P.gn + hh * HD + 8 * ch + 4);
#pragma unroll
        for (int i = 0; i < 4; ++i) { const int r = (tid >> 4) + 32 * i;
            float v[8]; float s1 = 0.f;
#pragma unroll
            for (int k = 0; k < 8; ++k) { v[k] = bf2f((bf16)raw[i][k]); s1 += v[k]; }
            s1 = sum16(s1);
            const float mu = s1 * (1.f / 128); float s2 = 0.f;
#pragma unroll
            for (int k = 0; k < 8; ++k) { v[k] -= mu; s2 += v[k] * v[k]; }
            s2 = sum16(s2);
            const float rs = rsqrtf(s2 * (1.f / 128) + EPS);
            u32x4 pk; pk.x = cvt_pk_bf16(v[0] * rs * g0.x, v[1] * rs * g0.y); pk.y = cvt_pk_bf16(v[2] * rs * g0.z, v[3] * rs * g0.w); pk.z = cvt_pk_bf16(v[4] * rs * g1.x, v[5] * rs * g1.y); pk.w = cvt_pk_bf16(v[6] * rs * g1.z, v[7] * rs * g1.w);
            *(LAS u32x4*)(VC + vimg_off(r, ch)) = pk; }
        __syncthreads();
        const int un = u + F.G; const bool has = un < NGM;
        if (has) { GM_DECODE(un, hhn, t0n); GM_LOADV(hhn, t0n); }
        const bf16* wrow = P.wsb + ((size_t)hh * CH + p) * CH + 4 * h;
        f32x16 acc[2];
#pragma unroll
        for (int dd = 0; dd < 2; ++dd)
#pragma unroll
            for (int r = 0; r < 16; ++r) acc[dd][r] = 0.f;
#pragma unroll
        for (int ks = 0; ks < 8; ++ks) { const s16x4 wl = *(const s16x4*)(wrow + 16 * ks), wh = *(const s16x4*)(wrow + 16 * ks + 8);
            const bf16x8 bfrag = (bf16x8){wl[0], wl[1], wl[2], wl[3], wh[0], wh[1], wh[2], wh[3]};
#pragma unroll
            for (int dd = 0; dd < 2; ++dd) { const int d0 = 2 * dp + dd; const s16x4 lo = vtr(VC + vb0 + 4096 * ks + 512 * d0), hi = vtr(VC + vb1 + 4096 * ks + 512 * d0);
                acc[dd] = MFMA32(((bf16x8){lo[0], lo[1], lo[2], lo[3], hi[0], hi[1], hi[2], hi[3]}), bfrag, acc[dd]); } }
        float ss = 0.f; bf16* yp = P.Y + trow * D + AW + hh * HD + 4 * h;
#pragma unroll
        for (int dd = 0; dd < 2; ++dd)
#pragma unroll
            for (int g4 = 0; g4 < 4; ++g4) { const int dof = 32 * (2 * dp + dd) + 8 * g4; const s16x4 u4 = uv[dd][g4];
                const float a = bf2f((bf16)u4[0]) * (acc[dd][4 * g4] + bias), b2 = bf2f((bf16)u4[1]) * (acc[dd][4 * g4 + 1] + bias), c2 = bf2f((bf16)u4[2]) * (acc[dd][4 * g4 + 2] + bias), d2 = bf2f((bf16)u4[3]) * (acc[dd][4 * g4 + 3] + bias);
                ss += (a * a + b2 * b2) + (c2 * c2 + d2 * d2); if constexpr (OUT_F8) { *(unsigned*)((unsigned char*)P.Y + trow * D + AW + hh * HD + 4 * h + dof) = pack4_fp8(a * YA_SCALE, b2 * YA_SCALE, c2 * YA_SCALE, d2 * YA_SCALE); } else { u32x2 wv; wv.x = cvt_pk_bf16(a, b2); wv.y = cvt_pk_bf16(c2, d2); *(u32x2*)(yp + dof) = wv; } }
        ss = xsum32(ss); if (h == 0) P.ssp[trow * SSPW + 8 + hh * 2 + dp] = ss;
        __syncthreads();
        if (!has) break;
        u = un;
    }
#undef GM_DECODE
#undef GM_LOADV
}
DI void p3_mixer(Frame& F, const Ptrs& P) {
    constexpr int NATT = NB * KVH * (S / 64);
    for (int u = blockIdx.x; u < NATT; u += F.G) { const int pb = u % (S / 64), kvh = (u / (S / 64)) % KVH, b = u / ((S / 64) * KVH); attn_unit(F, P, b, kvh, pb); }
    gmlp_phase(F, P);
}
DI void bf4_to_f(const u32x2 a, f32x4& v) { v.x = __uint_as_float(a.x << 16); v.y = __uint_as_float(a.x & 0xffff0000u); v.z = __uint_as_float(a.y << 16); v.w = __uint_as_float(a.y & 0xffff0000u); }
DI void p5_thin(Frame& F, const Ptrs& P) {
    LAS float* A1 = (LAS float*)F.lds; LAS float* A2 = A1 + D; LAS float* A3 = A2 + D; LAS float* WG = A3 + D;
    LAS unsigned* lcnt = (LAS unsigned*)(WG + NG * D); LAS unsigned* lbase = lcnt + NE; LAS unsigned* lent = lbase + NE; LAS float* lwt = (LAS float*)(lent + NE * 128);
    constexpr int RPB = 64; const int lane = F.lane;
    for (int i = F.tid; i < NG * D; i += NWAVES * 64) WG[i] = P.wrgT[i];
    for (int blk = blockIdx.x; blk < T / RPB; blk += F.G) {
        const int row_base = blk * RPB, b = row_base / S;
        u32x2 cm[8]; f32x4 cx[8];
        { const GAS u32x2* mr = (const GAS u32x2*)(P.MIX + (size_t)(row_base + F.wave) * D) + lane; const GAS f32x4* xr = (const GAS f32x4*)(P.x + (size_t)(row_base + F.wave) * D) + lane;
#pragma unroll
          for (int j = 0; j < 8; ++j) { cm[j] = __builtin_nontemporal_load(mr + 64 * j); cx[j] = __builtin_nontemporal_load(xr + 64 * j); } }
        __syncthreads();
        for (int i = F.tid; i < D; i += NWAVES * 64) { A1[i] = modv(P, b, 2 * D + i) * P.g_mix_post[i]; A2[i] = P.g_ffn_pre[i] * (1.f + modv(P, b, 4 * D + i)); A3[i] = modv(P, b, 3 * D + i); }
        if (F.tid < NE) lcnt[F.tid] = 0u;
        __syncthreads();
        for (int rr = F.wave; rr < RPB; rr += NWAVES) {
            const int row = row_base + rr; u32x2 nm[8]; f32x4 nx[8];
            if (rr + NWAVES < RPB) { const GAS u32x2* mr = (const GAS u32x2*)(P.MIX + (size_t)(row + NWAVES) * D) + lane; const GAS f32x4* xr = (const GAS f32x4*)(P.x + (size_t)(row + NWAVES) * D) + lane;
#pragma unroll
                for (int j = 0; j < 8; ++j) { nm[j] = __builtin_nontemporal_load(mr + 64 * j); nx[j] = __builtin_nontemporal_load(xr + 64 * j); } }
            f32x4 v[8]; float ss = 0.f;
#pragma unroll
            for (int j = 0; j < 8; ++j) { bf4_to_f(cm[j], v[j]); ss += (v[j].x * v[j].x + v[j].y * v[j].y) + (v[j].z * v[j].z + v[j].w * v[j].w); }
            float r = rsqrtf(wave_sum(ss) * (1.f / D) + EPS); ss = 0.f;
            GAS u32x2* ho = (GAS u32x2*)(P.HB + (size_t)row * D) + lane;
#pragma unroll
            for (int j = 0; j < 8; ++j) { const f32x4 a1 = *(const LAS f32x4*)(A1 + 4 * lane + 256 * j); v[j] = cx[j] + a1 * (v[j] * r); u32x2 hw; hw.x = cvt_pk_bf16(v[j].x, v[j].y); hw.y = cvt_pk_bf16(v[j].z, v[j].w); __builtin_nontemporal_store(hw, ho + 64 * j); ss += (v[j].x * v[j].x + v[j].y * v[j].y) + (v[j].z * v[j].z + v[j].w * v[j].w); }
            r = rsqrtf(wave_sum(ss) * (1.f / D) + EPS);
            float gl[4] = {0.f, 0.f, 0.f, 0.f}; GAS u32x2* fo = (GAS u32x2*)(P.A + (size_t)row * D) + lane;
#pragma unroll
            for (int j = 0; j < 8; ++j) { const int col = 4 * lane + 256 * j; const f32x4 a2 = *(const LAS f32x4*)(A2 + col), a3 = *(const LAS f32x4*)(A3 + col); v[j] = v[j] * r * a2 + a3;
                if constexpr (MOE_FP8) { ((GAS unsigned*)((unsigned char*)P.A + (size_t)row * D) + lane)[64 * j] = pack4_fp8(v[j].x, v[j].y, v[j].z, v[j].w); } else { u32x2 wv; wv.x = cvt_pk_bf16(v[j].x, v[j].y); wv.y = cvt_pk_bf16(v[j].z, v[j].w); fo[64 * j] = wv; }
#pragma unroll
                for (int g = 0; g < 4; ++g) { const f32x4 wg = *(const LAS f32x4*)(WG + g * D + col); gl[g] += (v[j].x * wg.x + v[j].y * wg.y) + (v[j].z * wg.z + v[j].w * wg.w); } }
            int gi = 0; float gmax = -1e30f;
#pragma unroll
            for (int g = 0; g < 4; ++g) { gl[g] = wave_sum(gl[g]) + P.b_rg[g]; if (gl[g] > gmax) { gmax = gl[g]; gi = g; } }
            float gsum = 0.f;
#pragma unroll
            for (int g = 0; g < 4; ++g) gsum += expf(gl[g] - gmax);
            const float gval = 1.f / gsum;
            float el[4] = {0.f, 0.f, 0.f, 0.f};
#pragma unroll
            for (int e = 0; e < 4; ++e) { const float* we = P.wreT + (size_t)(gi * EPG + e) * D;
#pragma unroll
                for (int j = 0; j < 8; ++j) { const f32x4 wv = *(const f32x4*)(we + 4 * lane + 256 * j); el[e] += (v[j].x * wv.x + v[j].y * wv.y) + (v[j].z * wv.z + v[j].w * wv.w); } }
            int e1 = 0; float m1 = -1e30f;
#pragma unroll
            for (int e = 0; e < 4; ++e) { el[e] = wave_sum(el[e]) + P.b_re[gi * EPG + e]; if (el[e] > m1) { m1 = el[e]; e1 = e; } }
            int e2 = 0; float m2 = -1e30f;
#pragma unroll
            for (int e = 0; e < 4; ++e) if (e != e1 && el[e] > m2) { m2 = el[e]; e2 = e; }
            const float p2 = expf(m2 - m1); const float w1 = gval / (1.f + p2), w2 = gval * p2 / (1.f + p2);
            if (lane == 0) {
                const int ea = gi * EPG + e1, eb = gi * EPG + e2;
                const unsigned pa = __hip_atomic_fetch_add(&lcnt[ea], 1u, __ATOMIC_RELAXED, __HIP_MEMORY_SCOPE_WORKGROUP); lent[ea * 128 + pa] = (unsigned)row * 2u; lwt[ea * 128 + pa] = w1;
                const unsigned pb = __hip_atomic_fetch_add(&lcnt[eb], 1u, __ATOMIC_RELAXED, __HIP_MEMORY_SCOPE_WORKGROUP); lent[eb * 128 + pb] = (unsigned)row * 2u + 1u; lwt[eb * 128 + pb] = w2;
            }
#pragma unroll
            for (int j = 0; j < 8; ++j) { cm[j] = nm[j]; cx[j] = nx[j]; }
        }
        __syncthreads();
        if (F.tid < NE) lbase[F.tid] = atomicAdd((unsigned*)P.ctlcnt + F.tid, lcnt[F.tid]);
        __syncthreads();
        for (int i = F.tid; i < NE * 128; i += NWAVES * 64) { const int e = i >> 7, k = i & 127; if ((unsigned)k < lcnt[e]) { const unsigned dst = lbase[e] + k; P.list[e * T + dst] = lent[i]; P.lw[e * T + dst] = lwt[i]; } }
    }
    __syncthreads();
}
DI void fp8x4_to_f(unsigned a, f32x4& v) { const f32x2 lo = __builtin_amdgcn_cvt_pk_f32_fp8((int)a, false), hi = __builtin_amdgcn_cvt_pk_f32_fp8((int)a, true); v.x = lo.x; v.y = lo.y; v.z = hi.x; v.w = hi.y; }
DI void p8_final(Frame& F, const Ptrs& P) {
    LAS float* A4 = (LAS float*)F.lds; constexpr int RPB = 64; const int lane = F.lane;
    typedef unsigned YT __attribute__((ext_vector_type(YK_FP8 ? 1 : 2)));
    constexpr int YROW = YK_FP8 ? D : 2 * D;
    for (int blk = blockIdx.x; blk < T / RPB; blk += F.G) {
        const int row_base = blk * RPB, b = row_base / S;
        YT c0[8], c1[8]; u32x2 ch[8];
#define P8_LOAD(Y0_, Y1_, H_, ROW_) do { const GAS YT* y0_ = (const GAS YT*)((const unsigned char*)P.YK + (size_t)(2 * (ROW_)) * YROW) + lane; const GAS YT* y1_ = (const GAS YT*)((const unsigned char*)P.YK + (size_t)(2 * (ROW_) + 1) * YROW) + lane; \
            const GAS u32x2* hr_ = (const GAS u32x2*)(P.HB + (size_t)(ROW_) * D) + lane; \
            _Pragma("unroll") for (int j = 0; j < 8; ++j) { Y0_[j] = __builtin_nontemporal_load(y0_ + 64 * j); Y1_[j] = __builtin_nontemporal_load(y1_ + 64 * j); H_[j] = __builtin_nontemporal_load(hr_ + 64 * j); } } while (0)
        P8_LOAD(c0, c1, ch, row_base + F.wave);
        __syncthreads();
        for (int i = F.tid; i < D; i += NWAVES * 64) A4[i] = modv(P, b, 5 * D + i) * P.g_ffn_post[i];
        __syncthreads();
        for (int rr = F.wave; rr < RPB; rr += NWAVES) {
            const int row = row_base + rr; YT n0[8], n1[8]; u32x2 nh[8];
            if (rr + NWAVES < RPB) P8_LOAD(n0, n1, nh, row + NWAVES);
            f32x4 v[8]; float ss = 0.f;
#pragma unroll
            for (int j = 0; j < 8; ++j) { f32x4 a, c;
                if constexpr (YK_FP8) { fp8x4_to_f(c0[j][0], a); fp8x4_to_f(c1[j][0], c); v[j] = (a + c) * (1.f / Y8_SCALE); }
                else { u32x2 t0, t1; t0.x = c0[j][0]; t0.y = c0[j][YK_FP8 ? 0 : 1]; t1.x = c1[j][0]; t1.y = c1[j][YK_FP8 ? 0 : 1]; bf4_to_f(t0, a); bf4_to_f(t1, c); v[j] = a + c; }
                ss += (v[j].x * v[j].x + v[j].y * v[j].y) + (v[j].z * v[j].z + v[j].w * v[j].w); }
            const float r = rsqrtf(wave_sum(ss) * (1.f / D) + EPS);
            GAS f32x4* ho = (GAS f32x4*)(P.out + (size_t)row * D) + lane;
#pragma unroll
            for (int j = 0; j < 8; ++j) { const f32x4 a4 = *(const LAS f32x4*)(A4 + 4 * lane + 256 * j); { f32x4 hv; bf4_to_f(ch[j], hv); __builtin_nontemporal_store(hv + a4 * (v[j] * r), ho + 64 * j); } }
#pragma unroll
            for (int j = 0; j < 8; ++j) { c0[j] = n0[j]; c1[j] = n1[j]; ch[j] = nh[j]; }
        }
#undef P8_LOAD
    }
}

struct Args { const void* in[23]; float* out; unsigned char* ws; int ph_lo, ph_hi; };
__global__ void __launch_bounds__(NWAVES * 64, 2) mega_fwd(Args args) {
    extern __shared__ __attribute__((aligned(16))) unsigned char lds[];
    Frame F;
    F.lds = (LAS unsigned char*)lds; F.MISC = (volatile LAS unsigned*)(F.lds + MISC_OFF);
    F.tid = threadIdx.x; F.lane = F.tid & 63; F.wave = __builtin_amdgcn_readfirstlane(F.tid >> 6); F.G = gridDim.x; F.gw = blockIdx.x * NWAVES + F.wave; F.NGW = F.G * NWAVES;
    unsigned char* ws = args.ws; F.ctl = (gu32*)(ws + WS_CTL);
#define PTRS(P) Ptrs P; { P.x = (const float*)args.in[0]; P.c = (const float*)args.in[1]; P.pos = (const int*)args.in[2]; P.w_ada = (const float*)args.in[3]; P.b_ada = (const float*)args.in[4]; P.g_mix_pre = (const float*)args.in[5]; \
    P.g_mix_post = (const float*)args.in[6]; P.w_in = (const float*)args.in[7]; P.sink = (const float*)args.in[8]; P.gn = (const float*)args.in[9]; P.wsp = (const float*)args.in[10]; P.bsp = (const float*)args.in[11]; \
    P.gg = (const float*)args.in[12]; P.w_out = (const float*)args.in[13]; P.g_ffn_pre = (const float*)args.in[14]; P.g_ffn_post = (const float*)args.in[15]; P.w_rg = (const float*)args.in[16]; P.b_rg = (const float*)args.in[17]; \
    P.w_re = (const float*)args.in[18]; P.b_re = (const float*)args.in[19]; P.w_gate = (const float*)args.in[20]; P.w_up = (const float*)args.in[21]; P.w_down = (const float*)args.in[22]; P.out = args.out; \
    P.mod = (float*)(ws + WS_MOD); P.rope = (float*)(ws + WS_ROPE); P.ssp = (float*)(ws + WS_SSP); P.list = (unsigned*)(ws + WS_LIST); P.lw = (float*)(ws + WS_LW); P.wrgT = (float*)(ws + WS_WRG); P.wreT = (float*)(ws + WS_WRE); \
    P.wsb = (bf16*)(ws + WS_WSB); P.WinT = (bf16*)(ws + WS_WIN); P.WoT = (bf16*)(ws + WS_WO); P.WguT = (bf16*)(ws + WS_WGU); P.WdT = (bf16*)(ws + WS_WD); P.A = (bf16*)(ws + WS_A); P.Z = (bf16*)(ws + WS_Z); P.Y = (bf16*)(ws + WS_Y); \
    P.MIX = (bf16*)(ws + WS_MIX); P.HB = (bf16*)(ws + WS_HB); P.ctlcnt = (unsigned*)(ws + WS_CTL) + CW_CNT; P.wmaxw = (unsigned*)(ws + WS_CTL) + CW_WMAX; P.asc = (float*)(ws + WS_ASC); P.HID = (bf16*)(ws + WS_HID); P.YK = (bf16*)(ws + WS_YK); }
    for (int u = F.tid; u < (LDS_BYTES - MISC_OFF) / 4; u += NWAVES * 64) ((LAS unsigned*)(F.lds + MISC_OFF))[u] = 0u;
    __syncthreads();
    const int lo = args.ph_lo, hi = args.ph_hi;
    XcdBarrier bar; bar.bar = (unsigned*)(F.ctl + CW_BAR); bar.x = 0; bar.st = nullptr;
    if (hi - lo > 1) bar = xcd_barrier_post((unsigned*)(F.ctl + CW_BAR), F.MISC + 24);
#define IN(k) (lo <= (k) && (k) < hi)
#define SEAM(k) do { if (IN(k) && IN((k) + 1)) xcd_barrier(bar); } while (0)
    LAS unsigned* tab = (LAS unsigned*)(F.lds + TAB_OFF); LAS int* tp = (LAS int*)(F.lds + MISC_OFF);

    if (IN(0)) { PTRS(P); p0_prologue(F, P); } SEAM(0);
    if (IN(1)) { PTRS(P); p1_norm(F, P); } SEAM(1);
    if (IN(2)) { PTRS(P); const int ncv = conv_wgs(F.G), gg2 = F.G - ncv;
        if ((int)blockIdx.x < gg2) { pg8::DenseOrder S2; S2.init(P.A, P.WinT, T, INW, INP_I8 ? D / 2 : D, gg2, (int)blockIdx.x);
            LAS f32x2* rt2 = (LAS f32x2*)tab; const float wq = INP_I8 ? __uint_as_float(__hip_atomic_load(P.wmaxw, RLX_AGENT)) * (1.f / 127.f) : 1.f;
            for (int idx = F.tid; idx < 4 * 256; idx += NWAVES * 64) { pg8::Unit u; if (S2.next(idx >> 8, u)) { const int row = u.pm * 256 + (idx & 255); rt2[idx] = (f32x2){INP_I8 ? P.asc[row] * wq : 1.f, (float)P.pos[row]}; } }
            __syncthreads();
            pg8::EpiInproj E{P.Z, rt2};
            pg8::gemm_core<pg8::EpiInproj, pg8::DenseOrder, false, false, INP_I8 ? 2 : 0>(F.lds, S2, E, nullptr); }
        else { LAS float* scr = (LAS float*)(F.lds + F.wave * 16384); const int per = CONV_ITEMS / (ncv * NWAVES), f0 = P0_SPLIT + (((int)blockIdx.x - gg2) * NWAVES + F.wave) * per; convert_range(P, f0, f0 + per, 1, scr, F.lane); } } SEAM(2);
    if (IN(3)) { PTRS(P); p3_mixer(F, P); } SEAM(3);
    if (IN(4)) { PTRS(P); pg8::DenseOrder S4; S4.init(P.Y, P.WoT, T, D, OUT_F8 ? D / 2 : D, F.G, (int)blockIdx.x);
        LAS f32x2* rr = (LAS f32x2*)tab; LAS unsigned* gt4 = tab + 4 * 512; pg8::Unit u; S4.gather = OUT_F8 != 0;
        for (int i = 0; i < 4 && S4.next(i, u); ++i) { f32x4 v[4];
#pragma unroll
            for (int j = 0; j < 4; ++j) { const int idx = F.tid + NWAVES * 64 * j; v[j] = ((idx & 7) < 6) ? *(const f32x4*)(P.ssp + (size_t)(u.pm * 256 + (idx >> 3)) * SSPW + 4 * (idx & 7)) : (f32x4){0.f, 0.f, 0.f, 0.f}; }
#pragma unroll
            for (int j = 0; j < 4; ++j) { const int idx = F.tid + NWAVES * 64 * j, r = idx >> 3, q = idx & 7; const float s = (v[j].x + v[j].y) + (v[j].z + v[j].w); float sa = q < 2 ? s : 0.f, sg = q < 2 ? 0.f : s;
                sa += __shfl_xor(sa, 1); sg += __shfl_xor(sg, 1); sg += __shfl_xor(sg, 2); sg += __shfl_xor(sg, 4);
                if (q == 0) { const float ra = rsqrtf(sa * (1.f / AW) + EPS), rg = rsqrtf(sg * (1.f / AW) + EPS); rr[i * 256 + r] = (f32x2){ra / rg, rg}; gt4[i * 256 + r] = (unsigned)(u.pm * 256 + r) * (unsigned)D; } } }
        __syncthreads();
        pg8::EpiOutproj E{P.MIX, rr};
        if constexpr (OUT_F8) pg8::gemm_core<pg8::EpiOutproj, pg8::DenseOrder, true, true, 1>(F.lds, S4, E, gt4);
        else pg8::gemm_core<pg8::EpiOutproj, pg8::DenseOrder, false, true, 0>(F.lds, S4, E, nullptr); } SEAM(4);
    if (IN(5)) { PTRS(P); p5_thin(F, P); } SEAM(5);
    if (IN(6) || IN(7)) {
        if (F.tid == 0) { int o = 0; for (int e = 0; e < NE; ++e) { tp[e] = o; o += (int)((__hip_atomic_load(F.ctl + CW_CNT + e, RLX_AGENT) + 255u) >> 8); } tp[NE] = o; }
        __syncthreads();
    }
    if (IN(6)) { PTRS(P); pg8::MoeOrder S6{(const char*)P.A, (const char*)P.WguT, MOE_FP8 ? D / 2 : D, FF / 128, (size_t)2048 * 2048 * (MOE_FP8 ? 1 : 2), tp, F.G, (int)blockIdx.x, true};
        LAS unsigned* gt = tab; LAS float* wt = (LAS float*)(tab + MAX_SLOTS * 256); pg8::Unit u;
#pragma unroll
        for (int j = 0; j < 4; ++j) { const int idx = F.tid + NWAVES * 64 * j, i = idx >> 8, r = idx & 255;
            if (i < MAX_SLOTS && S6.next(i, u)) { const unsigned n = __hip_atomic_load(F.ctl + CW_CNT + u.e, RLX_AGENT); const unsigned m = (unsigned)u.pm * 256u + r;
                const bool ok = m < n; gt[i * 256 + r] = ok ? (P.list[u.e * T + m] >> 1) * (unsigned)(MOE_FP8 ? D : D * 2) : 0u; wt[i * 256 + r] = ok ? P.lw[u.e * T + m] : 0.f; } }
        __syncthreads();
        pg8::EpiGateUp E{(unsigned char*)P.HID, wt, tp}; pg8::gemm_core<pg8::EpiGateUp, pg8::MoeOrder, true, false, MOE_FP8 ? 1 : 0>(F.lds, S6, E, gt);
        if (conv_wgs(F.G)) {
            LAS float* scr = (LAS float*)(F.lds + F.wave * 16384); const int nmax = S6.max_units();
            int nidle = 0, myidx = -1;
            if (S6.xcd()) { const int W = F.G >> 3, mx = (int)blockIdx.x & 7, mr = (int)blockIdx.x >> 3;
                for (int x = 0; x < 8; ++x) { const int U = S6.group_units(x), q = (U + W - 1) / W; const int first = (q < nmax) ? 0 : U - (nmax - 1) * W;
                    if (x == mx && mr >= first) myidx = nidle + (mr - first); nidle += W - first; } }
            else { const int rem = (tp[NE] * (FF / 128)) % F.G; if (rem != 0) { nidle = F.G - rem; if ((int)blockIdx.x >= rem) myidx = (int)blockIdx.x - rem; } }
            if (nidle < 96) convert_range(P, I_DOWN0 + F.gw, NITEMS, F.NGW, scr, F.lane);
            else if (myidx >= 0) convert_range(P, I_DOWN0 + myidx * NWAVES + F.wave, NITEMS, nidle * NWAVES, scr, F.lane);
        } } SEAM(6);
    if (IN(7)) { PTRS(P); pg8::MoeOrder S7{(const char*)P.HID, (const char*)P.WdT, MOE_FP8 ? FF / 2 : FF, D / 256, (size_t)2048 * 1024 * (MOE_FP8 ? 1 : 2), tp, F.G, (int)blockIdx.x, true};
        LAS unsigned* dt = tab; LAS unsigned* gt7 = tab + MAX_SLOTS * 256; pg8::Unit u;
#pragma unroll
        for (int j = 0; j < 4; ++j) { const int idx = F.tid + NWAVES * 64 * j, i = idx >> 8, r = idx & 255;
            if (i < MAX_SLOTS && S7.next(i, u)) { const unsigned n = __hip_atomic_load(F.ctl + CW_CNT + u.e, RLX_AGENT); const unsigned m = (unsigned)u.pm * 256u + r;
                dt[i * 256 + r] = m < n ? P.list[u.e * T + m] : 0xffffffffu; gt7[i * 256 + r] = (unsigned)((tp[u.e] + u.pm) * 256 + r) * (unsigned)(MOE_FP8 ? FF : FF * 2); } }
        __syncthreads();
        pg8::EpiDown E{(unsigned char*)P.YK, dt}; pg8::gemm_core<pg8::EpiDown, pg8::MoeOrder, true, false, MOE_FP8 ? 1 : 0>(F.lds, S7, E, gt7); } SEAM(7);
    if (IN(8)) { PTRS(P); p8_final(F, P);
        if (__hip_atomic_load(F.ctl + CW_BAR + XB_TMO, RLX_AGENT) != 0u) { const float q = __builtin_nanf(""); for (int row = F.gw; row < T; row += F.NGW) for (int j = F.lane; j < D; j += 64) P.out[(size_t)row * D + j] = q; } }
#undef IN
#undef SEAM
}

extern "C" void kernel_launch(void* const* d_in, const int* in_sizes, int n_in, void* d_out, int out_size, void* d_ws, size_t ws_size, hipStream_t stream) {
    static int grid = 0;
    if (grid == 0) {
        if (n_in != 23 || in_sizes[0] != T * D || out_size != T * D || ws_size < WS_END) { fprintf(stderr, "kernel_launch: unexpected shapes / workspace (%d inputs, ws %zu)\n", n_in, ws_size); grid = -1; return; }
        int dev = 0, cus = 0, per_cu = 0;
        if (hipGetDevice(&dev) != hipSuccess || hipDeviceGetAttribute(&cus, hipDeviceAttributeMultiprocessorCount, dev) != hipSuccess) { grid = -1; return; }
        if (hipFuncSetAttribute((const void*)mega_fwd, hipFuncAttributeMaxDynamicSharedMemorySize, LDS_BYTES) != hipSuccess) { grid = -1; return; }
        if (hipOccupancyMaxActiveBlocksPerMultiprocessor(&per_cu, (const void*)mega_fwd, NWAVES * 64, LDS_BYTES) != hipSuccess || per_cu < 1) fprintf(stderr, "kernel_launch: occupancy query says %d\n", per_cu);
        (void)hipGetLastError();
        grid = cus;
        if (grid != 256) fprintf(stderr, "kernel_launch: %d CUs (built for 256)\n", grid);
    }
    if (grid < 0) return;
    (void)hipMemsetAsync((char*)d_ws + WS_CTL, 0, CTL_ZERO_BYTES, stream);
    Args a; memset(&a, 0, sizeof(a));
    for (int i = 0; i < 23; ++i) a.in[i] = d_in[i];
    a.out = (float*)d_out; a.ws = (unsigned char*)d_ws; a.ph_lo = 0; a.ph_hi = 9;
    hipLaunchKernelGGL(mega_fwd, dim3(grid), dim3(NWAVES * 64), LDS_BYTES, stream, a);
}
```

```cpp
#include <hip/hip_runtime.h>
#include <cstdio>
#include <cstdint>
#include <cstring>

#ifndef MOE_FP8
#define MOE_FP8 1
#endif

constexpr int D = 2048, NB = 8, S = 2048, T = NB * S, HD = 128, AW = 1024, AH = 8, KVH = 2, GH = 8, INW = 3584;
constexpr int WIN = 128, CH = 128, NG = 4, EPG = 4, NE = 16, FF = 1024, NMOD = 6, MODW = NMOD * D;
constexpr int OQ = 0, OK_ = 1024, OV = 1280, OU = 1536, OVG = 2560;
constexpr float EPS = 1e-6f;
constexpr float LOG2E = 1.4426950408889634f;
constexpr float C2 = 0.08838834764831845f * LOG2E;
constexpr int HID_ROWS = 2 * T + NE * 256;
constexpr int SSPW = 32;

typedef unsigned short bf16;
typedef short bf16x8 __attribute__((ext_vector_type(8)));
typedef short s16x4 __attribute__((ext_vector_type(4)));
typedef short v4i16_t __attribute__((ext_vector_type(4)));
typedef float f32x2 __attribute__((ext_vector_type(2)));
typedef float f32x4 __attribute__((ext_vector_type(4)));
typedef float f32x16 __attribute__((ext_vector_type(16)));
typedef unsigned u32x2 __attribute__((ext_vector_type(2)));
typedef unsigned u32x4 __attribute__((ext_vector_type(4)));
#define DI __device__ __forceinline__
#define GAS __attribute__((address_space(1)))
#define LAS __attribute__((address_space(3)))
typedef GAS unsigned gu32;

constexpr size_t MiB = 1u << 20;
constexpr size_t WS_CTL = 0, CTL_ZERO_BYTES = 65536;
constexpr size_t WS_MOD = 1 * MiB;
constexpr size_t WS_ROPE = 3 * MiB;
constexpr size_t WS_SSP = 5 * MiB;
constexpr size_t WS_LIST = 7 * MiB;
constexpr size_t WS_LW = 8 * MiB;
constexpr size_t WS_WRG = 9 * MiB;
constexpr size_t WS_WRE = 9 * MiB + 65536;
constexpr size_t WS_WSB = 9 * MiB + 262144;
constexpr size_t WS_ASC = 9 * MiB + 786432;
constexpr size_t WS_WIN = 10 * MiB;
constexpr size_t WS_WO = 24 * MiB;
constexpr size_t WS_WGU = 32 * MiB;
constexpr size_t WS_WD = 160 * MiB;
constexpr size_t WS_A = 224 * MiB;
constexpr size_t WS_Z = 288 * MiB;
constexpr size_t WS_Y = 400 * MiB;
constexpr size_t WS_HB = 400 * MiB;
constexpr size_t WS_MIX = 464 * MiB;
constexpr size_t WS_HID = 288 * MiB;
constexpr size_t WS_YK = 464 * MiB;
constexpr size_t WS_END = 592 * MiB;
constexpr int CW_TMO = 0, CW_CNT = 64, CW_WMAX = 96, CW_BAR = 4096;

DI float bf2f(bf16 h) { return __uint_as_float(((unsigned)h) << 16); }
DI bf16 f2bf(float f) { unsigned u = __float_as_uint(f); return (bf16)((u + 0x7fffu + ((u >> 16) & 1u)) >> 16); }
DI unsigned cvt_pk_bf16(float lo, float hi) { unsigned r; asm volatile("v_cvt_pk_bf16_f32 %0, %1, %2" : "=v"(r) : "v"(lo), "v"(hi)); return r; }
typedef float f32x2_t __attribute__((ext_vector_type(2))); typedef __bf16 bf16x2_t __attribute__((ext_vector_type(2)));
DI unsigned cvtpk_s(float lo, float hi) { f32x2_t v = {lo, hi}; bf16x2_t b = __builtin_convertvector(v, bf16x2_t); return __builtin_bit_cast(unsigned, b); }
DI unsigned pack4_i8(float a, float b, float c, float d) { const int q0 = (int)rintf(a), q1 = (int)rintf(b), q2 = (int)rintf(c), q3 = (int)rintf(d); return (unsigned)(q0 & 255) | ((unsigned)(q1 & 255) << 8) | ((unsigned)(q2 & 255) << 16) | ((unsigned)q3 << 24); }
DI float clamp127(float v) { return __builtin_amdgcn_fmed3f(v, -127.f, 127.f); }
DI u32x4 pair16(u32x2 a, u32x2 b) { const auto r0 = __builtin_amdgcn_permlane16_swap(a.x, b.x, false, false); const auto r1 = __builtin_amdgcn_permlane16_swap(a.y, b.y, false, false); return (u32x4){r0[0], r1[0], r0[1], r1[1]}; }
constexpr float W8_SCALE = 32.f, H8_SCALE = 16.f, Y8_SCALE = 64.f, YA_SCALE = 4.f;
DI unsigned dpp_ror8(unsigned v) { return (unsigned)__builtin_amdgcn_update_dpp(0, (int)v, 0x128, 0xF, 0xF, true); }
DI void rows8_store(bf16* base  , size_t pitch, int fr, const u32x4 w0, const u32x4 w1) {
    const u32x4 x = {dpp_ror8(w1.x), dpp_ror8(w1.y), dpp_ror8(w1.z), dpp_ror8(w1.w)}; const bool hi = fr >= 8;
    const u32x4 a = hi ? x : w0, b = hi ? w0 : x;
    bf16* pa = base + (size_t)(fr & 7) * pitch + (hi ? 32 : 0); bf16* pb = base + (size_t)((fr & 7) + 8) * pitch + (hi ? 0 : 32);
    *(u32x4*)pa = a; *(u32x4*)pb = b;
}
DI float clamp8(float v) { return __builtin_amdgcn_fmed3f(v, -448.f, 448.f); }
DI unsigned pack4_fp8(float a, float b, float c, float d) { int p = 0; p = __builtin_amdgcn_cvt_pk_fp8_f32(clamp8(a), clamp8(b), p, false); p = __builtin_amdgcn_cvt_pk_fp8_f32(clamp8(c), clamp8(d), p, true); return (unsigned)p; }
typedef int v4i32 __attribute__((ext_vector_type(4))); typedef int v8i32 __attribute__((ext_vector_type(8)));
DI v8i32 cat8(bf16x8 lo, bf16x8 hi) { const v4i32 a = __builtin_bit_cast(v4i32, lo), b = __builtin_bit_cast(v4i32, hi); return __builtin_shufflevector(a, b, 0, 1, 2, 3, 4, 5, 6, 7); }
#define DPP_ADD(v, ctrl) (v) += __builtin_bit_cast(float, __builtin_amdgcn_update_dpp(0, __builtin_bit_cast(int, (v)), (ctrl), 0xF, 0xF, true))
DI float wave_sum(float v) {
    DPP_ADD(v, 0x111); DPP_ADD(v, 0x112); DPP_ADD(v, 0x114); DPP_ADD(v, 0x118);
    const int b = __builtin_bit_cast(int, v);
    return (__builtin_bit_cast(float, __builtin_amdgcn_readlane(b, 15)) + __builtin_bit_cast(float, __builtin_amdgcn_readlane(b, 31))) + (__builtin_bit_cast(float, __builtin_amdgcn_readlane(b, 47)) + __builtin_bit_cast(float, __builtin_amdgcn_readlane(b, 63)));
}
DI float sum16(float v) {
    DPP_ADD(v, 0xB1); DPP_ADD(v, 0x4E); DPP_ADD(v, 0x141); DPP_ADD(v, 0x140); return v;
}
DI float xsum32(float v) { const auto rr = __builtin_amdgcn_permlane32_swap(__float_as_uint(v), __float_as_uint(v), false, false); return __uint_as_float(rr[0]) + __uint_as_float(rr[1]); }
DI float xmax32(float v) { const auto rr = __builtin_amdgcn_permlane32_swap(__float_as_uint(v), __float_as_uint(v), false, false); return fmaxf(__uint_as_float(rr[0]), __uint_as_float(rr[1])); }
DI float xother32(float v) { const unsigned b = __float_as_uint(v); const auto rr = __builtin_amdgcn_permlane32_swap(b, b, false, false); return __uint_as_float(rr[0] ^ rr[1] ^ b); }
DI f32x2 gelu_pk(f32x2 v) {
    const f32x2 av = __builtin_elementwise_abs(v), d = av * 0.2316418882f + 1.0f;
    f32x2 t; t.x = __builtin_amdgcn_rcpf(d.x); t.y = __builtin_amdgcn_rcpf(d.y);
    f32x2 q = t * 0.5307027145f + (-0.7265760135f); q = q * t + 0.7107068705f; q = q * t + (-0.142248368f); q = q * t + 0.127414796f; q = q * t;
    const f32x2 s = (v * v) * (-0.72134752044f);
    f32x2 e; e.x = __builtin_amdgcn_exp2f(s.x); e.y = __builtin_amdgcn_exp2f(s.y);
    const f32x2 m = v * (q * e), r = v - m;
    f32x2 o; o.x = v.x < 0.f ? m.x : r.x; o.y = v.y < 0.f ? m.y : r.y; return o;
}
#define LDS_WAIT() asm volatile("s_waitcnt lgkmcnt(0)" ::: "memory")
#define VM_WAIT() asm volatile("s_waitcnt vmcnt(0)" ::: "memory")
#define RLX_AGENT __ATOMIC_RELAXED, __HIP_MEMORY_SCOPE_AGENT

namespace pg8 {
constexpr int BM = 256, BK = 64, HALF = 128, HTB = HALF * BK * 2, NXCD = 8, WGM = 8;
__host__ __device__ __forceinline__ int lds_byte(int r, int c) { const int st = (r >> 4) * 2 + (c >> 5), rr = r & 15, cc = c & 31, ob = rr * 64 + cc * 2; return st * 1024 + (ob ^ (((ob >> 9) & 1) << 5)); }
__host__ __device__ __forceinline__ void stage_rc(int b, int& R, int& C) { const int st = b / 1024, sb = b % 1024, swz = sb ^ (((sb >> 9) & 1) << 5); R = (st >> 1) * 16 + swz / 64; C = (st & 1) * 32 + (swz % 64) / 2; }
__host__ __device__ __forceinline__ int perm32(int rho) { const int n = rho >> 4, i = rho & 15; return 8 * (i >> 2) + 4 * n + (i & 3); }

struct Unit { int pm, pn, e, slot; };

struct DenseOrder {
    const char* A; const char* Bt; int K; int nM, nN, nwg, G, c;
    DI void init(const void* A_, const void* Bt_, int M, int N, int K_, int G_, int c_) { A = (const char*)A_; Bt = (const char*)Bt_; K = K_; nM = M / BM; nN = N / BM; nwg = nM * nN; G = G_; c = c_; }
    DI bool next(int i, Unit& u) const {
        const long L = (long)i * G + c; if (L >= nwg) return false;
        int wgid = (int)L; { const int q = nwg / NXCD, r = nwg % NXCD, xcd = wgid % NXCD, off = wgid / NXCD; wgid = (xcd < r ? xcd * (q + 1) : r * (q + 1) + (xcd - r) * q) + off; }
        const int nig = WGM * nN, gid = wgid / nig, fm = gid * WGM, gsz = (nM - fm) < WGM ? (nM - fm) : WGM;
        u.pm = fm + ((wgid % nig) % gsz); u.pn = (wgid % nig) / gsz; u.e = 0; u.slot = i; return true;
    }
    bool gather = false;
    DI const char* a_base(const Unit& u) const { return gather ? A : A + (size_t)u.pm * BM * K * 2; }
    DI const char* b_base(const Unit& u) const { return Bt + (size_t)u.pn * BM * K * 2; }
};
#ifndef INP_I8
#define INP_I8 1
#endif
#ifndef OUT_F8
#define OUT_F8 1
#endif
#ifndef YK_FP8
#define YK_FP8 1
#endif
#ifndef MOE_XCD
#define MOE_XCD 0
#endif
struct MoeOrder {
    const char* A; const char* Bt; int K, nN; size_t bstride  ; LAS const int* tp; int G, c; bool gather; bool xg = false;
    DI bool xcd() const { return (MOE_XCD || xg) && (G % 8 == 0); }
    DI int group_units(int x) const { return ((tp[x + 1] - tp[x]) + (tp[x + 9] - tp[x + 8])) * nN; }
    DI int my_units() const {
        if (xcd()) { const int W = G >> 3, r = c >> 3, U = group_units(c & 7); return U > r ? (U - r + W - 1) / W : 0; }
        const int tot = tp[NE] * nN; return tot > c ? (tot - c + G - 1) / G : 0;
    }
    DI int max_units() const {
        if (xcd()) { const int W = G >> 3; int m = 0;
#pragma unroll
            for (int x = 0; x < 8; ++x) { const int q = (group_units(x) + W - 1) / W; m = q > m ? q : m; } return m; }
        return (tp[NE] * nN + G - 1) / G;
    }
    DI bool next(int i, Unit& u) const {
        if (xcd()) {
            const int x = c & 7, r = c >> 3, W = G >> 3; const int t0 = tp[x + 1] - tp[x], t1 = tp[x + 9] - tp[x + 8];
            int k = r + W * i; if (k >= (t0 + t1) * nN) return false;
            int e = x; if (k >= t0 * nN) { e = x + 8; k -= t0 * nN; }
            u.e = e; u.pm = k / nN; u.pn = k % nN; u.slot = i; return true;
        }
        const int L = i * G + c; const int tot = tp[NE] * nN; if (L >= tot) return false;
        const int mt = L / nN; u.pn = L % nN; int e = 0;
#pragma unroll
        for (int k = 1; k < NE; ++k) e += (mt >= tp[k]) ? 1 : 0;
        u.e = e; u.pm = mt - tp[e]; u.slot = i; return true;
    }
    DI const char* a_base(const Unit& u) const { return gather ? A : A + (size_t)(tp[u.e] + u.pm) * BM * K * 2; }
    DI const char* b_base(const Unit& u) const { return Bt + (size_t)u.e * bstride + (size_t)u.pn * BM * K * 2; }
};

template <class Epi, class Sched, bool GATHER, bool MIDK, int QM = 0>
DI void gemm_core(LAS unsigned char* lds, const Sched& S, const Epi& E, LAS const unsigned* gtab) {
    const int tid = threadIdx.x, wid = __builtin_amdgcn_readfirstlane(tid >> 6), lane = tid & 63, wr = wid >> 2, wc = wid & 3, fr = lane & 15, fq = lane >> 4;
    const int K = S.K, nt = K / BK;
    unsigned voffA[2], voffB[2]; int RA[2];
#pragma unroll
    for (int i = 0; i < 2; ++i) { int R, C; stage_rc(tid * 16 + i * 8192, R, C); const int Rb = Epi::PERM ? (64 * (R >> 5) + perm32(R & 31)) : R;
        RA[i] = R; voffA[i] = GATHER ? (unsigned)(C * 2) : (unsigned)(R * K + C) * 2u; voffB[i] = (unsigned)(Rb * K + C) * 2u; }
    const size_t kstep = (size_t)(BK * 2);
    const size_t hstep = (size_t)HALF * K * 2;
    const size_t bhstep = Epi::PERM ? (size_t)32 * K * 2 : hstep;
    const unsigned ldsw = (unsigned)wid * 1024u;
    const int aoff = lds_byte(wr * 64 + fr, fq * 8), boff = lds_byte(wc * 32 + fr, fq * 8);
#define PG8_SA(b, h) (((b) * 2 + (h)) * HTB)
#define PG8_SB(b, h) ((4 + (b) * 2 + (h)) * HTB)
#define PG8_STAGE(bufoff, gbase, voff) do { _Pragma("unroll") for (int _i = 0; _i < 2; ++_i) \
        __builtin_amdgcn_global_load_lds((const unsigned*)((const char*)(gbase) + (voff)[_i]), (LAS unsigned*)(lds + (bufoff) + ldsw + _i * 8192), 16, 0, 0); } while (0)
#define PG8_STAGE_A(bufoff, kb, h, VA) do { if constexpr (GATHER) { PG8_STAGE(bufoff, kb, VA[h]); } else { PG8_STAGE(bufoff, (kb) + (h) * hstep, voffA); } } while (0)
#define PG8_LDA(dst, b, h) do { _Pragma("unroll") for (int m = 0; m < 4; ++m) _Pragma("unroll") for (int k = 0; k < 2; ++k) dst[m][k] = *(const LAS bf16x8*)(lds + PG8_SA(b, h) + aoff + m * 2048 + k * 1024); } while (0)
#define PG8_LDB(dst, b, h) do { _Pragma("unroll") for (int n = 0; n < 2; ++n) _Pragma("unroll") for (int k = 0; k < 2; ++k) dst[n][k] = *(const LAS bf16x8*)(lds + PG8_SB(b, h) + boff + n * 2048 + k * 1024); } while (0)
#define PG8_MMA(ai, bj, At, Bt) do { __builtin_amdgcn_s_setprio(1); _Pragma("unroll") for (int m = 0; m < 4; ++m) _Pragma("unroll") for (int n = 0; n < 2; ++n) { \
        if constexpr (QM == 1) acc[ai][bj][m][n] = __builtin_amdgcn_mfma_scale_f32_16x16x128_f8f6f4(cat8(Bt[n][0], Bt[n][1]), cat8(At[m][0], At[m][1]), acc[ai][bj][m][n], 0, 0, 0, 0x7f7f7f7f, 0, 0x7f7f7f7f); \
        else if constexpr (QM == 2) { _Pragma("unroll") for (int k = 0; k < 2; ++k) acc[ai][bj][m][n] = __builtin_bit_cast(f32x4, __builtin_amdgcn_mfma_i32_16x16x64_i8(__builtin_bit_cast(v4i32, Bt[n][k]), __builtin_bit_cast(v4i32, At[m][k]), __builtin_bit_cast(v4i32, acc[ai][bj][m][n]), 0, 0, 0)); } \
        else { _Pragma("unroll") for (int k = 0; k < 2; ++k) acc[ai][bj][m][n] = __builtin_amdgcn_mfma_f32_16x16x32_bf16(Bt[n][k], At[m][k], acc[ai][bj][m][n], 0, 0, 0); } } __builtin_amdgcn_s_setprio(0); } while (0)
#define PG8_WAIT_V(n) asm volatile("s_waitcnt vmcnt(" #n ")" ::: "memory")
#define PG8_WAIT_L(n) asm volatile("s_waitcnt lgkmcnt(" #n ")" ::: "memory")
#define PG8_BAR __builtin_amdgcn_s_barrier()
#define PG8_SCHED __builtin_amdgcn_sched_barrier(0)
    Unit cur, nxt; int ui = 0;
    if (!S.next(0, cur)) return;
    f32x4 acc[2][2][4][2];
#pragma unroll
    for (int a = 0; a < 2; ++a)
#pragma unroll
        for (int b = 0; b < 2; ++b)
#pragma unroll
            for (int m = 0; m < 4; ++m)
#pragma unroll
                for (int n = 0; n < 2; ++n) acc[a][b][m][n] = (f32x4){0.f, 0.f, 0.f, 0.f};
    bf16x8 At[4][2], B0[2][2], B1[2][2];
    unsigned va[2][2];
    if constexpr (GATHER) {
#pragma unroll
        for (int h = 0; h < 2; ++h)
#pragma unroll
            for (int i = 0; i < 2; ++i) va[h][i] = gtab[cur.slot * 256 + h * 128 + RA[i]] + voffA[i];
    }
    const char* cA = S.a_base(cur); const char* cB = S.b_base(cur);
    PG8_STAGE(PG8_SB(0, 0), cB, voffB); PG8_STAGE(PG8_SB(0, 1), cB + bhstep, voffB); PG8_STAGE_A(PG8_SA(0, 0), cA, 0, va); PG8_STAGE_A(PG8_SA(0, 1), cA, 1, va);
    if (wr == 1) PG8_BAR;
    PG8_WAIT_V(2); PG8_BAR;
    PG8_STAGE(PG8_SB(1, 0), cB + kstep, voffB); PG8_STAGE_A(PG8_SA(1, 0), cA + kstep, 0, va); PG8_STAGE(PG8_SB(1, 1), cB + bhstep + kstep, voffB);
    PG8_WAIT_V(6); PG8_BAR;
    for (;;) {
        const bool has_next = S.next(ui + 1, nxt);
        const char* nA = has_next ? S.a_base(nxt) : cA; const char* nB = has_next ? S.b_base(nxt) : cB;
#pragma clang loop unroll(disable)
        for (int t = 0; t < nt; t += 2) {
            const bool last = (t == nt - 2);
            const char* a1 = cA + (size_t)(t + 1) * kstep;
            const char* a2 = last ? nA : cA + (size_t)(t + 2) * kstep; const char* b2 = last ? nB : cB + (size_t)(t + 2) * kstep;
            const char* a3 = a2 + kstep; const char* b3 = b2 + kstep;
            if constexpr (MIDK) { if (t == nt / 2) E.midk(acc, cur, wr, fr); }
            PG8_LDB(B0, 0, 0); PG8_LDB(B1, 0, 1); PG8_SCHED; PG8_LDA(At, 0, 0); PG8_STAGE_A(PG8_SA(1, 1), a1, 1, va);
            if constexpr (GATHER) { if (last && has_next) {
#pragma unroll
                for (int h = 0; h < 2; ++h)
#pragma unroll
                    for (int i = 0; i < 2; ++i) va[h][i] = gtab[nxt.slot * 256 + h * 128 + RA[i]] + voffA[i]; } }
            PG8_WAIT_V(8); PG8_WAIT_L(0); PG8_BAR; PG8_MMA(0, 0, At, B0); PG8_MMA(0, 1, At, B1); PG8_BAR; PG8_SCHED;
            PG8_LDA(At, 0, 1); PG8_STAGE(PG8_SB(0, 0), b2, voffB); PG8_STAGE(PG8_SB(0, 1), b2 + bhstep, voffB); PG8_STAGE_A(PG8_SA(0, 0), a2, 0, va);
            PG8_WAIT_V(8); PG8_WAIT_L(0); PG8_BAR; PG8_MMA(1, 0, At, B0); PG8_MMA(1, 1, At, B1); PG8_BAR; PG8_SCHED;
            PG8_LDB(B0, 1, 0); PG8_LDB(B1, 1, 1); PG8_SCHED; PG8_LDA(At, 1, 0); PG8_STAGE_A(PG8_SA(0, 1), a2, 1, va);
            PG8_WAIT_V(8); PG8_WAIT_L(0); PG8_BAR; PG8_MMA(0, 0, At, B0); PG8_MMA(0, 1, At, B1); PG8_BAR; PG8_SCHED;
            PG8_LDA(At, 1, 1); PG8_STAGE(PG8_SB(1, 0), b3, voffB); PG8_STAGE(PG8_SB(1, 1), b3 + bhstep, voffB); PG8_STAGE_A(PG8_SA(1, 0), a3, 0, va);
            PG8_WAIT_V(8); PG8_WAIT_L(0); PG8_BAR; PG8_MMA(1, 0, At, B0); PG8_MMA(1, 1, At, B1); PG8_BAR; PG8_SCHED;
        }
        if (wr == 0) PG8_BAR;
        E(acc, cur, wr, wc, fr, fq);
        if (!has_next) break;
#pragma unroll
        for (int a = 0; a < 2; ++a)
#pragma unroll
            for (int b = 0; b < 2; ++b)
#pragma unroll
                for (int m = 0; m < 4; ++m)
#pragma unroll
                    for (int n = 0; n < 2; ++n) acc[a][b][m][n] = (f32x4){0.f, 0.f, 0.f, 0.f};
        cur = nxt; cA = nA; cB = nB; ++ui;
        if (wr == 1) PG8_BAR;
    }
    PG8_WAIT_V(0);
    PG8_BAR;
#undef PG8_SA
#undef PG8_SB
#undef PG8_STAGE
#undef PG8_STAGE_A
#undef PG8_LDA
#undef PG8_LDB
#undef PG8_MMA
#undef PG8_WAIT_V
#undef PG8_WAIT_L
#undef PG8_BAR
#undef PG8_SCHED
}

struct EpiInproj {
    static constexpr bool PERM = true;
    bf16* Z; LAS const f32x2* rt;
    DI void operator()(const f32x4 (&acc)[2][2][4][2], const Unit& u, int wr, int wc, int fr, int fq) const {
        const int row0 = u.pm * BM + wr * 64 + fr, col0 = u.pn * BM + wc * 64 + 8 * fq;
        const int kind = u.pn < 4 ? 0 : (u.pn == 4 ? 1 : (u.pn == 5 ? 2 : 3));
        const float sc = kind == 0 ? C2 : 1.f;
        const bool dorope = (kind <= 1) && ((wc & 1) == 0);
        float ch[8], cl[8]; const bool odd = (fq & 1) != 0;
        ch[0] = odd ? 2.250790858e-04f : 1.591549367e-01f; cl[0] = odd ? -6.755001072e-12f : 6.420638243e-09f;
        ch[1] = odd ? 9.911730740e-05f : 7.008652389e-02f; cl[1] = odd ? 1.969154007e-12f : -2.302696700e-09f;
        ch[2] = odd ? 4.364795313e-05f : 3.086376376e-02f; cl[2] = odd ? -3.416928741e-13f : -3.597993847e-10f;
        ch[3] = odd ? 1.922110096e-05f : 1.359137055e-02f; cl[3] = odd ? -2.712567042e-13f : 9.086624508e-11f;
        ch[4] = odd ? 8.464330676e-06f : 5.985185504e-03f; cl[4] = odd ? 1.318804142e-13f : 2.087540557e-10f;
        ch[5] = odd ? 3.727408512e-06f : 2.635675948e-03f; cl[5] = odd ? 9.029300745e-14f : -4.944578774e-11f;
        ch[6] = odd ? 1.641426252e-06f : 1.160663669e-03f; cl[6] = odd ? 1.098673646e-14f : -2.775752544e-11f;
        ch[7] = odd ? 7.228293271e-07f : 5.111175124e-04f; cl[7] = odd ? -2.017673985e-14f : -7.822671330e-12f;
#pragma unroll
        for (int ai = 0; ai < 2; ++ai)
#pragma unroll
            for (int m = 0; m < 4; ++m) { const int rl = ai * HALF + wr * 64 + m * 16 + fr; u32x4 wv[2];
                const f32x2 te = rt[u.slot * 256 + rl]; const float dq = te.x;
                f32x4 cs[2], sn[2];
                if (dorope) { const float p = te.y;
#pragma unroll
                    for (int n = 0; n < 2; ++n)
#pragma unroll
                        for (int j = 0; j < 4; ++j) { const int k = 4 * n + j; const float r = p * ch[k], e = __builtin_fmaf(p, ch[k], -r), x = __builtin_amdgcn_fractf(r) + __builtin_fmaf(p, cl[k], e);
                            cs[n][j] = __builtin_amdgcn_cosf(x); sn[n][j] = __builtin_amdgcn_sinf(x); }
                }
#pragma unroll
                for (int bj = 0; bj < 2; ++bj) { f32x4 v[2] = {acc[ai][bj][m][0], acc[ai][bj][m][1]};
                    if constexpr (INP_I8) { _Pragma("unroll") for (int n = 0; n < 2; ++n) { const v4i32 iv = __builtin_bit_cast(v4i32, v[n]); v[n] = (f32x4){(float)iv[0], (float)iv[1], (float)iv[2], (float)iv[3]} * dq; } }
                    if (kind == 3) {
#pragma unroll
                        for (int n = 0; n < 2; ++n) { f32x2 a = gelu_pk((f32x2){v[n][0], v[n][1]}), b = gelu_pk((f32x2){v[n][2], v[n][3]}); v[n] = (f32x4){a.x, a.y, b.x, b.y}; }
                    } else if (dorope && bj == 0) {
#pragma unroll
                        for (int n = 0; n < 2; ++n)
#pragma unroll
                            for (int j = 0; j < 4; ++j) { const float mine = v[n][j], other = xother32(mine);
                                v[n][j] = (fq < 2) ? (mine * cs[n][j] - other * sn[n][j]) : (mine * cs[n][j] + other * sn[n][j]); }
                    }
                    v[0] = v[0] * sc; v[1] = v[1] * sc;
                    wv[bj].x = cvt_pk_bf16(v[0][0], v[0][1]); wv[bj].y = cvt_pk_bf16(v[0][2], v[0][3]); wv[bj].z = cvt_pk_bf16(v[1][0], v[1][1]); wv[bj].w = cvt_pk_bf16(v[1][2], v[1][3]); }
                rows8_store(Z + (size_t)(u.pm * BM + rl - fr) * INW + col0, INW, fr, wv[0], wv[1]); }
    }
};
struct EpiOutproj {
    static constexpr bool PERM = true;
    bf16* MIX; LAS const f32x2* rr;
    DI void midk(f32x4 (&acc)[2][2][4][2], const Unit& u, int wr, int fr) const {
#pragma unroll
        for (int ai = 0; ai < 2; ++ai)
#pragma unroll
            for (int m = 0; m < 4; ++m) { const float s = rr[u.slot * 256 + ai * HALF + wr * 64 + m * 16 + fr].x;
#pragma unroll
                for (int bj = 0; bj < 2; ++bj)
#pragma unroll
                    for (int n = 0; n < 2; ++n) acc[ai][bj][m][n] = acc[ai][bj][m][n] * s; }
    }
    DI void operator()(const f32x4 (&acc)[2][2][4][2], const Unit& u, int wr, int wc, int fr, int fq) const {
        const int col0 = u.pn * BM + wc * 64 + 8 * fq;
#pragma unroll
        for (int ai = 0; ai < 2; ++ai)
#pragma unroll
            for (int m = 0; m < 4; ++m) { const int rl = ai * HALF + wr * 64 + m * 16 + fr; const float s = rr[u.slot * 256 + rl].y * (OUT_F8 ? 1.f / (W8_SCALE * YA_SCALE) : 1.f); u32x4 wv[2];
#pragma unroll
                for (int bj = 0; bj < 2; ++bj) { const f32x4 v0 = acc[ai][bj][m][0] * s, v1 = acc[ai][bj][m][1] * s;
                    wv[bj].x = cvt_pk_bf16(v0[0], v0[1]); wv[bj].y = cvt_pk_bf16(v0[2], v0[3]); wv[bj].z = cvt_pk_bf16(v1[0], v1[1]); wv[bj].w = cvt_pk_bf16(v1[2], v1[3]); }
                rows8_store(MIX + (size_t)(u.pm * BM + rl - fr) * D + col0, D, fr, wv[0], wv[1]); }
    }
};
struct EpiGateUp {
    static constexpr bool PERM = true;
    unsigned char* HID; LAS const float* wtab; LAS const int* tp;
    DI void operator()(const f32x4 (&acc)[2][2][4][2], const Unit& u, int wr, int wc, int fr, int fq) const {
        const int col0 = u.pn * HALF + wc * 32 + 8 * fq; const size_t rt = (size_t)(tp[u.e] + u.pm) * BM;
        constexpr float in_sc = MOE_FP8 ? 1.f / W8_SCALE : 1.f, out_sc = MOE_FP8 ? H8_SCALE : 1.f;
#pragma unroll
        for (int ai = 0; ai < 2; ++ai)
#pragma unroll
            for (int mp = 0; mp < 2; ++mp) { u32x2 pk8[2]; u32x4 pk16[2];
#pragma unroll
                for (int q = 0; q < 2; ++q) { const int m = 2 * mp + q; const int rl = ai * HALF + wr * 64 + m * 16 + fr; const float w = wtab[u.slot * 256 + rl] * out_sc; f32x4 o[2];
#pragma unroll
                    for (int n = 0; n < 2; ++n)
#pragma unroll
                        for (int j = 0; j < 4; ++j) { const float g = acc[ai][0][m][n][j] * in_sc, up = acc[ai][1][m][n][j] * in_sc; o[n][j] = g * __builtin_amdgcn_rcpf(1.f + __builtin_amdgcn_exp2f(-g * LOG2E)) * up * w; }
                    if constexpr (MOE_FP8) { pk8[q].x = pack4_fp8(o[0][0], o[0][1], o[0][2], o[0][3]); pk8[q].y = pack4_fp8(o[1][0], o[1][1], o[1][2], o[1][3]); }
                    else { pk16[q].x = cvt_pk_bf16(o[0][0], o[0][1]); pk16[q].y = cvt_pk_bf16(o[0][2], o[0][3]); pk16[q].z = cvt_pk_bf16(o[1][0], o[1][1]); pk16[q].w = cvt_pk_bf16(o[1][2], o[1][3]); } }
                const int rl0 = ai * HALF + wr * 64 + (2 * mp) * 16 + fr;
                if constexpr (MOE_FP8) {
                    const u32x4 w16 = pair16(pk8[0], pk8[1]); const int odd = fq & 1;
                    *(u32x4*)(HID + (rt + rl0 + 16 * odd) * FF + col0 - 8 * odd) = w16; }
                else { *(u32x4*)((bf16*)HID + (rt + rl0) * FF + col0) = pk16[0]; *(u32x4*)((bf16*)HID + (rt + rl0 + 16) * FF + col0) = pk16[1]; } }
    }
};
struct EpiDown {
    static constexpr bool PERM = true;
    unsigned char* YK; LAS const unsigned* dtab;
    DI void operator()(const f32x4 (&acc)[2][2][4][2], const Unit& u, int wr, int wc, int fr, int fq) const {
        const int col0 = u.pn * BM + wc * 64 + 8 * fq; constexpr float sc = (MOE_FP8 ? 1.f / (W8_SCALE * H8_SCALE) : 1.f) * (YK_FP8 ? Y8_SCALE : 1.f);
#pragma unroll
        for (int ai = 0; ai < 2; ++ai)
#pragma unroll
            for (int m = 0; m < 4; ++m) { const int rl = ai * HALF + wr * 64 + m * 16 + fr; const unsigned dst = dtab[u.slot * 256 + rl];
                if constexpr (YK_FP8) { u32x2 w[2];
#pragma unroll
                    for (int bj = 0; bj < 2; ++bj) { const f32x4 v0 = acc[ai][bj][m][0] * sc, v1 = acc[ai][bj][m][1] * sc; w[bj].x = pack4_fp8(v0[0], v0[1], v0[2], v0[3]); w[bj].y = pack4_fp8(v1[0], v1[1], v1[2], v1[3]); }
                    const u32x4 w16 = pair16(w[0], w[1]); const int odd = fq & 1;
                    if (dst != 0xffffffffu) *(u32x4*)(YK + (size_t)dst * D + col0 - 8 * odd + 32 * odd) = w16;
                } else { if (dst != 0xffffffffu) {
#pragma unroll
                    for (int bj = 0; bj < 2; ++bj) { const f32x4 v0 = acc[ai][bj][m][0] * sc, v1 = acc[ai][bj][m][1] * sc;
                        u32x4 w; w.x = cvt_pk_bf16(v0[0], v0[1]); w.y = cvt_pk_bf16(v0[2], v0[3]); w.z = cvt_pk_bf16(v1[0], v1[1]); w.w = cvt_pk_bf16(v1[2], v1[3]);
                        *(u32x4*)((bf16*)YK + (size_t)dst * D + col0 + bj * 32) = w; } } } }
    }
};
}

#define XB_TMO      128
#define XB_XCNT(j)  (256  + 64 * (j))
#define XB_XSUB(j)  (1280 + 64 * (j))
#define XB_XGEN(j)  (2304 + 64 * (j))
#define XB_TOP      3328
#define XB_TOPGEN   3392
#define XCD_BAR_WORDS 3456
#define XB_SPIN_CAP (1u << 18)
DI unsigned xb_ld(unsigned* p)              { return __hip_atomic_load(p, __ATOMIC_RELAXED, __HIP_MEMORY_SCOPE_AGENT); }
DI unsigned xb_add(unsigned* p, unsigned v) { return __hip_atomic_fetch_add(p, v, __ATOMIC_RELAXED, __HIP_MEMORY_SCOPE_AGENT); }
DI unsigned xb_xcc_id() { return (unsigned)__builtin_amdgcn_s_getreg((3 << 11) | 20) & 0xFu; }
#define XB_SPIN(cond, bar) do { unsigned _sp = 0; while (cond) { __builtin_amdgcn_s_sleep(1); \
    if ((++_sp & 255u) == 0u) { if (xb_ld(&(bar)[XB_TMO])) break; if (_sp > XB_SPIN_CAP) { atomicAdd(&(bar)[XB_TMO], 1u); break; } } } } while (0)
struct XcdBarrier { unsigned* bar; unsigned x; volatile LAS unsigned* st; };
DI XcdBarrier xcd_barrier_post(unsigned* bar, volatile LAS unsigned* st) {
    XcdBarrier b; b.bar = bar; b.x = xb_xcc_id(); b.st = st;
    if (threadIdx.x == 0) (void)xb_add(&bar[XB_XCNT(b.x)], 1u);
    return b;
}
DI void xcd_barrier_complete(unsigned* bar, unsigned x, unsigned& nloc, unsigned& nx) {
    const unsigned G = gridDim.x * gridDim.y * gridDim.z;
    unsigned sum, cnt, mine, sp = 0u;
    for (;;) {
        sum = 0u; cnt = 0u; mine = 0u;
#pragma unroll
        for (unsigned j = 0; j < 16; ++j) { const unsigned c = xb_ld(&bar[XB_XCNT(j)]); sum += c; cnt += (c > 0u) ? 1u : 0u; mine = (j == x) ? c : mine; }
        if (sum == G) break;
        __builtin_amdgcn_s_sleep(1);
        if ((++sp & 255u) == 0u) { if (xb_ld(&bar[XB_TMO])) break; if (sp > XB_SPIN_CAP) { atomicAdd(&bar[XB_TMO], 1u); break; } }
    }
    nloc = mine > 0u ? mine : 1u; nx = cnt > 0u ? cnt : 1u;
}
DI void xcd_barrier(const XcdBarrier& b) {
    asm volatile("s_waitcnt vmcnt(0)" ::: "memory");
    __syncthreads();
    if (threadIdx.x == 0) {
        unsigned* bar = b.bar;
        __builtin_amdgcn_s_waitcnt(0);
        unsigned nloc = b.st[0], nx = b.st[1];
        if (nloc == 0u) { xcd_barrier_complete(bar, b.x, nloc, nx); b.st[0] = nloc; b.st[1] = nx; }
        const unsigned old = xb_add(&bar[XB_XSUB(b.x)], 1u);
        const unsigned gen = old / nloc;
        if (old + 1u == (gen + 1u) * nloc) {
            __builtin_amdgcn_fence(__ATOMIC_RELEASE, "agent");
            asm volatile("s_waitcnt vmcnt(0)" ::: "memory");
            const unsigned og = xb_add(&bar[XB_TOP], 1u);
            const unsigned tg = og / nx;
            if (og + 1u == (tg + 1u) * nx) xb_add(&bar[XB_TOPGEN], 1u);
            else XB_SPIN(xb_ld(&bar[XB_TOPGEN]) == tg, bar);
            __builtin_amdgcn_fence(__ATOMIC_ACQUIRE, "agent");
            xb_add(&bar[XB_XGEN(b.x)], 1u);
            asm volatile("s_waitcnt vmcnt(0)" ::: "memory");
        } else {
            XB_SPIN(xb_ld(&bar[XB_XGEN(b.x)]) == gen, bar);
            __builtin_amdgcn_fence(__ATOMIC_ACQUIRE, "agent");
            asm volatile("s_waitcnt vmcnt(0)" ::: "memory");
        }
    }
    __syncthreads();
}

constexpr int NWAVES = 8;
constexpr int RING_BYTES = 131072;
constexpr int TAB_OFF = RING_BYTES;
constexpr int TAB_BYTES = 14336;
constexpr int MISC_OFF = TAB_OFF + TAB_BYTES;
constexpr int LDS_BYTES = 147456;
static_assert(MISC_OFF + 256 <= LDS_BYTES, "LDS map");
constexpr int MAX_SLOTS = 7;

struct Frame { LAS unsigned char* lds; volatile LAS unsigned* MISC; gu32* ctl; int tid, lane, wave, G, gw, NGW; };
struct Ptrs {
    const float *x, *c, *w_ada, *b_ada, *g_mix_pre, *g_mix_post, *w_in, *sink, *gn, *wsp, *bsp, *gg, *w_out, *g_ffn_pre, *g_ffn_post, *w_rg, *b_rg, *w_re, *b_re, *w_gate, *w_up, *w_down;
    const int* pos; float* out;
    float *mod, *rope, *ssp, *lw, *wrgT, *wreT, *asc; unsigned* list; unsigned* ctlcnt; unsigned* wmaxw; bf16 *MIX, *HB, *wsb, *WinT, *WoT, *WguT, *WdT, *A, *Z, *Y, *HID, *YK;
};
constexpr int I_IN = 32 * 112, I_OUT = 32 * 64, I_E = 1024, NITEMS = I_IN + I_OUT + 3 * NE * I_E;
#ifndef CONV_ITEMS
#define CONV_ITEMS 11264
#endif
constexpr int I_DOWN0 = I_IN + I_OUT + 2 * NE * I_E;
constexpr int P0_SPLIT = I_DOWN0 - CONV_ITEMS;
DI int conv_wgs(int G) { return (G == 256) ? 32 : 0; }
DI int conv_split(int G) { return conv_wgs(G) ? P0_SPLIT : NITEMS; }
struct ItemDesc { const float* W; bf16* WT; const float* kscale; int K, N, k0, n0, out_row0, f8; float qs; };
DI ItemDesc decode_item(const Ptrs& P, int it) {
    ItemDesc d; int r = it; d.kscale = nullptr; d.f8 = 0; d.qs = 1.f;
    if (r < I_IN) { d.W = P.w_in; d.WT = P.WinT; d.K = D; d.N = INW; d.k0 = 64 * (r / 112); d.n0 = 32 * (r % 112); d.out_row0 = d.n0;
        if (INP_I8) { d.f8 = 2; d.qs = 127.f / fmaxf(__uint_as_float(__hip_atomic_load(P.wmaxw, RLX_AGENT)), 1e-30f); } return d; } r -= I_IN;
    if (r < I_OUT) { d.W = P.w_out; d.WT = P.WoT; d.K = D; d.N = D; d.k0 = 64 * (r / 64); d.n0 = 32 * (r % 64); d.out_row0 = d.n0; d.kscale = P.gg; if (OUT_F8) d.f8 = 1; return d; } r -= I_OUT;
    const int which = r / (NE * I_E); r -= which * NE * I_E; const int e = r / I_E; r -= e * I_E; d.f8 = MOE_FP8;
    if (which < 2) { d.W = (which ? P.w_up : P.w_gate) + (size_t)e * D * FF; d.WT = P.WguT + (size_t)e * 2048 * (MOE_FP8 ? 1024 : 2048); d.K = D; d.N = FF; d.k0 = 64 * (r / 32); d.n0 = 32 * (r % 32); d.out_row0 = (d.n0 >> 7) * 256 + ((d.n0 >> 5) & 3) * 64 + which * 32; }
    else { d.W = P.w_down + (size_t)e * FF * D; d.WT = P.WdT + (size_t)e * 2048 * (MOE_FP8 ? 512 : 1024); d.K = FF; d.N = D; d.k0 = 64 * (r / 64); d.n0 = 32 * (r % 64); d.out_row0 = d.n0; }
    return d;
}
DI void item_load(const ItemDesc& d, f32x4 (&v)[8], int lane) {
    const float* p = d.W + (size_t)(d.k0 + (lane >> 3)) * d.N + d.n0 + 4 * (lane & 7);
#pragma unroll
    for (int i = 0; i < 8; ++i) v[i] = __builtin_nontemporal_load((const GAS f32x4*)(p + (size_t)(8 * i) * d.N));
}
DI void item_finish(const ItemDesc& d, const f32x4 (&v)[8], LAS float* scr, int lane) {
    const int kr = lane >> 3, q = lane & 7;
#pragma unroll
    for (int i = 0; i < 8; ++i) { f32x4 x = v[i]; if (d.kscale) x = x * d.kscale[d.k0 + 8 * i + kr]; LAS float* w = scr + (8 * i + kr) * 33 + 4 * q; w[0] = x.x; w[1] = x.y; w[2] = x.z; w[3] = x.w; }
    LDS_WAIT(); asm volatile("" ::: "memory");
    const int c = lane & 7;
    if (d.f8 == 2) {
#pragma unroll
        for (int j = 0; j < 4; ++j) { const int n = (lane >> 3) + 8 * j; const LAS float* s = scr + (8 * c) * 33 + n; const float q = d.qs;
            u32x2 o; o.x = pack4_i8(clamp127(s[0 * 33] * q), clamp127(s[1 * 33] * q), clamp127(s[2 * 33] * q), clamp127(s[3 * 33] * q)); o.y = pack4_i8(clamp127(s[4 * 33] * q), clamp127(s[5 * 33] * q), clamp127(s[6 * 33] * q), clamp127(s[7 * 33] * q));
            *(GAS u32x2*)((unsigned char*)d.WT + (size_t)(d.out_row0 + n) * d.K + d.k0 + 8 * c) = o; }
    } else if (d.f8) {
#pragma unroll
        for (int j = 0; j < 4; ++j) { const int n = (lane >> 3) + 8 * j; const LAS float* s = scr + (8 * c) * 33 + n;
            u32x2 o; o.x = pack4_fp8(s[0 * 33] * W8_SCALE, s[1 * 33] * W8_SCALE, s[2 * 33] * W8_SCALE, s[3 * 33] * W8_SCALE); o.y = pack4_fp8(s[4 * 33] * W8_SCALE, s[5 * 33] * W8_SCALE, s[6 * 33] * W8_SCALE, s[7 * 33] * W8_SCALE);
            __builtin_nontemporal_store(o, (GAS u32x2*)((unsigned char*)d.WT + (size_t)(d.out_row0 + n) * d.K + d.k0 + 8 * c)); }
    } else {
#pragma unroll
        for (int j = 0; j < 4; ++j) { const int n = (lane >> 3) + 8 * j; const LAS float* s = scr + (8 * c) * 33 + n;
            u32x4 o; o.x = cvtpk_s(s[0 * 33], s[1 * 33]); o.y = cvtpk_s(s[2 * 33], s[3 * 33]); o.z = cvtpk_s(s[4 * 33], s[5 * 33]); o.w = cvtpk_s(s[6 * 33], s[7 * 33]);
            *(GAS u32x4*)(d.WT + (size_t)(d.out_row0 + n) * d.K + d.k0 + 8 * c) = o; }
    }
    LDS_WAIT(); asm volatile("" ::: "memory");
}
#ifndef CONV_DEPTH
#define CONV_DEPTH 2
#endif
DI void convert_range(const Ptrs& P, int first, int end, int stride, LAS float* scr, int lane) {
    constexpr int DEPTH = CONV_DEPTH; f32x4 buf[DEPTH][8]; ItemDesc dsc[DEPTH];
#pragma unroll
    for (int q = 0; q < DEPTH - 1; ++q) { const int it = first + q * stride; dsc[q] = decode_item(P, it < end ? it : first); if (it < end) item_load(dsc[q], buf[q], lane); }
    for (int base = first; base < end; base += DEPTH * stride) {
#pragma unroll
        for (int q = 0; q < DEPTH; ++q) {
            const int it = base + q * stride; if (it >= end) return;
            const int pf = it + (DEPTH - 1) * stride; constexpr int dummy = 0; (void)dummy;
            if (pf < end) { dsc[(q + DEPTH - 1) % DEPTH] = decode_item(P, pf); item_load(dsc[(q + DEPTH - 1) % DEPTH], buf[(q + DEPTH - 1) % DEPTH], lane); }
            item_finish(dsc[q], buf[q], scr, lane);
        }
    }
}
DI float modv(const Ptrs& P, int b, int idx) { const float* m = P.mod + b * MODW + idx; return ((m[0] + m[NB * MODW]) + (m[2 * NB * MODW] + m[3 * NB * MODW])) + P.b_ada[idx]; }
DI void p0_prologue(Frame& F, const Ptrs& P) {
    LAS float* ca = (LAS float*)F.lds; LAS float* PP = (LAS float*)(F.lds + 65536);
    const int kg = F.tid >> 4, c4 = F.tid & 15; constexpr int NITM = 4 * (MODW / 64), NSCAN = D * INW / 4;
    const int gt = F.gw * 64 + F.lane, NGT = F.NGW * 64;
    f32x4 cv[8];
#pragma unroll
    for (int j = 0; j < 8; ++j) cv[j] = *(const GAS f32x4*)(P.c + 4 * (F.tid + NWAVES * 64 * j));
#define P0_LOADW(W_, ITEM_) do { const int chunk_ = (ITEM_) % (MODW / 64), kq_ = (ITEM_) / (MODW / 64); const float* wp_ = P.w_ada + (size_t)(512 * kq_ + kg) * MODW + 64 * chunk_ + 4 * c4; \
        _Pragma("unroll") for (int i = 0; i < 16; ++i) W_[i] = __builtin_nontemporal_load((const GAS f32x4*)(wp_ + (size_t)(32 * i) * MODW)); } while (0)
    int item = blockIdx.x; f32x4 w[16];
    if (item < NITM) P0_LOADW(w, item);
    float t_rg = 0.f, t_re = 0.f, t_sb = 0.f;
    if (gt < NG * D) t_rg = P.w_rg[(gt % D) * NG + gt / D];
    if (gt < NE * D) t_re = P.w_re[(gt % D) * NE + gt / D];
    if (gt < GH * CH * CH) t_sb = P.wsp[gt];
    const GAS f32x4* wsc = (const GAS f32x4*)P.w_in; int sbase = gt; f32x4 sv[7]; bool spend = false; float wm = 0.f;
#define P0_SCAN_ISSUE() do { _Pragma("unroll") for (int j = 0; j < 7; ++j) { const int idx_ = sbase + j * NGT; sv[j] = (INP_I8 && idx_ < NSCAN) ? wsc[idx_] : (f32x4){0.f, 0.f, 0.f, 0.f}; } sbase += 7 * NGT; spend = true; } while (0)
#define P0_SCAN_EAT() do { _Pragma("unroll") for (int j = 0; j < 7; ++j) wm = fmaxf(wm, fmaxf(fmaxf(fabsf(sv[j].x), fabsf(sv[j].y)), fmaxf(fabsf(sv[j].z), fabsf(sv[j].w)))); spend = false; } while (0)
    if (INP_I8 && sbase < NSCAN) P0_SCAN_ISSUE();
    asm volatile("" ::: "memory");
#pragma unroll
    for (int j = 0; j < 8; ++j) { f32x4 o; o.x = cv[j].x / (1.f + expf(-cv[j].x)); o.y = cv[j].y / (1.f + expf(-cv[j].y)); o.z = cv[j].z / (1.f + expf(-cv[j].z)); o.w = cv[j].w / (1.f + expf(-cv[j].w)); *(LAS f32x4*)(ca + 4 * (F.tid + NWAVES * 64 * j)) = o; }
    __syncthreads();
    while (item < NITM) {
        const int nitem = item + F.G; const bool has = nitem < NITM; f32x4 wn[16];
        if (has) P0_LOADW(wn, nitem);
        asm volatile("" ::: "memory");
        const int chunk = item % (MODW / 64), kq = item / (MODW / 64), kbase = 512 * kq;
        f32x4 acc[NB];
#pragma unroll
        for (int b = 0; b < NB; ++b) acc[b] = (f32x4){0.f, 0.f, 0.f, 0.f};
#pragma unroll
        for (int i = 0; i < 16; ++i) { const int k = kbase + kg + 32 * i;
#pragma unroll
            for (int b = 0; b < NB; ++b) acc[b] += w[i] * ca[b * D + k]; }
#pragma unroll
        for (int b = 0; b < NB; ++b) *(LAS f32x4*)(PP + (kg * 8 + b) * 64 + 4 * c4) = acc[b];
        __syncthreads();
        { const int b = F.tid >> 6, col = F.tid & 63; float sacc = 0.f;
#pragma unroll 8
          for (int k2 = 0; k2 < 32; ++k2) sacc += PP[(k2 * 8 + b) * 64 + col];
          P.mod[(size_t)kq * NB * MODW + b * MODW + 64 * chunk + col] = sacc; }
        __syncthreads();
        if (spend) { P0_SCAN_EAT(); if (sbase < NSCAN) P0_SCAN_ISSUE(); }
        asm volatile("" ::: "memory");
        if (has) {
#pragma unroll
            for (int i = 0; i < 16; ++i) w[i] = wn[i]; }
        item = nitem;
    }
    while (spend) { P0_SCAN_EAT(); if (sbase < NSCAN) P0_SCAN_ISSUE(); }
#undef P0_LOADW
#undef P0_SCAN_ISSUE
#undef P0_SCAN_EAT
    if constexpr (INP_I8) {
#pragma unroll
        for (int o = 1; o < 64; o <<= 1) wm = fmaxf(wm, __shfl_xor(wm, o));
        if (F.lane == 0) atomicMax(P.wmaxw, __float_as_uint(wm)); }
    if (gt < NG * D) P.wrgT[gt] = t_rg;
    if (gt < NE * D) P.wreT[gt] = t_re;
    if (gt < GH * CH * CH) P.wsb[gt] = f2bf(t_sb);
    for (int i = gt + NGT; i < NG * D; i += NGT) { const int g = i / D, k = i % D; P.wrgT[i] = P.w_rg[k * NG + g]; }
    for (int i = gt + NGT; i < NE * D; i += NGT) { const int ge = i / D, k = i % D; P.wreT[i] = P.w_re[k * NE + ge]; }
    for (int i = gt + NGT; i < GH * CH * CH; i += NGT) P.wsb[i] = f2bf(P.wsp[i]);
}
DI void p1_norm(Frame& F, const Ptrs& P) {
    LAS float* G1 = (LAS float*)F.lds; LAS float* H1 = G1 + D; constexpr int RPB = 64; const int lane = F.lane;
    for (int blk = blockIdx.x; blk < T / RPB; blk += F.G) {
        const int row_base = blk * RPB, b = row_base / S;
        f32x4 cur[8];
        { const GAS f32x4* xr = (const GAS f32x4*)(P.x + (size_t)(row_base + F.wave) * D) + lane;
#pragma unroll
          for (int j = 0; j < 8; ++j) cur[j] = __builtin_nontemporal_load(xr + 64 * j); }
        __syncthreads();
        for (int i = F.tid; i < D; i += NWAVES * 64) { G1[i] = P.g_mix_pre[i] * (1.f + modv(P, b, D + i)); H1[i] = modv(P, b, i); }
        __syncthreads();
        for (int rr = F.wave; rr < RPB; rr += NWAVES) {
            const int row = row_base + rr; f32x4 nxt[8];
            if (rr + NWAVES < RPB) { const GAS f32x4* xr = (const GAS f32x4*)(P.x + (size_t)(row + NWAVES) * D) + lane;
#pragma unroll
                for (int j = 0; j < 8; ++j) nxt[j] = __builtin_nontemporal_load(xr + 64 * j); }
            float ss = 0.f;
#pragma unroll
            for (int j = 0; j < 8; ++j) ss += (cur[j].x * cur[j].x + cur[j].y * cur[j].y) + (cur[j].z * cur[j].z + cur[j].w * cur[j].w);
            const float r = rsqrtf(wave_sum(ss) * (1.f / D) + EPS);
            if constexpr (INP_I8) {
                f32x4 av[8]; float amax = 1e-30f;
#pragma unroll
                for (int j = 0; j < 8; ++j) { const int col = 4 * lane + 256 * j; const f32x4 g = *(const LAS f32x4*)(G1 + col), sh = *(const LAS f32x4*)(H1 + col);
                    av[j] = cur[j] * r * g + sh; amax = fmaxf(amax, fmaxf(fmaxf(fabsf(av[j].x), fabsf(av[j].y)), fmaxf(fabsf(av[j].z), fabsf(av[j].w)))); }
#pragma unroll
                for (int o = 1; o < 64; o <<= 1) amax = fmaxf(amax, __shfl_xor(amax, o));
                const float qs = 127.f / amax; if (lane == 0) P.asc[row] = amax * (1.f / 127.f);
                GAS unsigned* o4 = (GAS unsigned*)((unsigned char*)P.A + (size_t)row * D) + lane;
#pragma unroll
                for (int j = 0; j < 8; ++j) o4[64 * j] = pack4_i8(av[j].x * qs, av[j].y * qs, av[j].z * qs, av[j].w * qs);
            } else {
            GAS u32x2* o8 = (GAS u32x2*)(P.A + (size_t)row * D) + lane;
#pragma unroll
            for (int j = 0; j < 8; ++j) { const int col = 4 * lane + 256 * j; const f32x4 g = *(const LAS f32x4*)(G1 + col), sh = *(const LAS f32x4*)(H1 + col);
                const f32x4 a = cur[j] * r * g + sh; u32x2 w; w.x = cvt_pk_bf16(a.x, a.y); w.y = cvt_pk_bf16(a.z, a.w); o8[64 * j] = w; }
            }
#pragma unroll
            for (int j = 0; j < 8; ++j) cur[j] = nxt[j];
        }
    }
    __syncthreads();
    { LAS float* scr = (LAS float*)(F.lds + F.wave * 16384);
      const int gwx = (F.G == 256) ? ((((int)blockIdx.x & 7) * 32 + ((int)blockIdx.x >> 3)) * NWAVES + F.wave) : F.gw;
      convert_range(P, gwx, conv_split(F.G), F.NGW, scr, F.lane); }
}
DI int crow(int r, int hi) { return (r & 3) + 8 * (r >> 2) + 4 * hi; }
#define KSWZ(row, colB) ((row) * 256 + ((colB) ^ (((row) & 7) << 4)))
DI int vimg_off(int row, int ch) { return 2048 * (row >> 3) + 512 * (ch >> 2) + 64 * (row & 7) + 16 * ((ch & 3) ^ ((row >> 2) & 3)); }
DI s16x4 vtr(LAS const unsigned char* p) { return __builtin_bit_cast(s16x4, __builtin_amdgcn_ds_read_tr16_b64_v4i16((LAS v4i16_t*)p)); }
DI bf16x8 pack8(const f32x16& x, int s) {
    u32x4 p; p.x = cvtpk_s(x[8 * s + 0], x[8 * s + 1]); p.y = cvtpk_s(x[8 * s + 2], x[8 * s + 3]); p.z = cvtpk_s(x[8 * s + 4], x[8 * s + 5]); p.w = cvtpk_s(x[8 * s + 6], x[8 * s + 7]);
    return __builtin_bit_cast(bf16x8, p);
}
#define MFMA32(a, b, c) __builtin_amdgcn_mfma_f32_32x32x16_bf16((a), (b), (c), 0, 0, 0)
DI void attn_unit(Frame& F, const Ptrs& P, int b, int kvh, int pb) {
    const int tid = F.tid, lane = F.lane, w = F.wave, r32 = lane & 31, h = lane >> 5;
    const int hq = kvh * 4 + (w >> 1), p0 = pb * 64, qpos = p0 + 32 * (w & 1) + r32; const size_t trow = (size_t)b * S + qpos;
    LAS unsigned char* Kb = F.lds; LAS unsigned char* Vb = F.lds + 32768;
    bf16x8 qr[8]; { const bf16* qp = P.Z + trow * INW + OQ + hq * HD + 8 * h;
#pragma unroll
        for (int d0 = 0; d0 < 8; ++d0) qr[d0] = *(const bf16x8*)(qp + 16 * d0); }
    f32x16 o[4];
#pragma unroll
    for (int d0 = 0; d0 < 4; ++d0)
#pragma unroll
        for (int r = 0; r < 16; ++r) o[d0][r] = 0.f;
    float m_run = P.sink[hq] * LOG2E, l_run = 1.f;
    const int j_lo = p0 >= 128 ? 0 : (128 - p0) / 64, j_hi = (S - 64 - p0 + 128) / 64 < 4 ? (S - 64 - p0 + 128) / 64 : 4;
    const int sr = tid >> 4, sc = tid & 15;
    const bf16* kg = P.Z + ((size_t)b * S) * INW + OK_ + kvh * HD + sc * 8; const bf16* vg = P.Z + ((size_t)b * S) * INW + OV + kvh * HD + sc * 8;
    const int kst0 = KSWZ(sr, sc * 16), kst1 = KSWZ(sr + 32, sc * 16), vst0 = vimg_off(sr, sc), vst1 = vimg_off(sr + 32, sc);
    const int q4 = (lane & 15) >> 2, p4 = lane & 3, g16 = (lane >> 4) & 1;
    const int vb0 = 64 * (4 * h + q4) + 16 * ((2 * g16 + (p4 >> 1)) ^ h) + 8 * (p4 & 1), vb1 = 2048 + 64 * (4 * h + q4) + 16 * ((2 * g16 + (p4 >> 1)) ^ (h + 2)) + 8 * (p4 & 1);
    bf16x8 sk0, sk1, sv0, sv1;
#define ATT_LOAD(j) do { const size_t r0 = (size_t)(p0 - 128 + 64 * (j) + sr) * INW; sk0 = *(const bf16x8*)(kg + r0); sk1 = *(const bf16x8*)(kg + r0 + (size_t)32 * INW); sv0 = *(const bf16x8*)(vg + r0); sv1 = *(const bf16x8*)(vg + r0 + (size_t)32 * INW); } while (0)
#define ATT_WRITE(bi) do { *(LAS bf16x8*)(Kb + (bi) * 16384 + kst0) = sk0; *(LAS bf16x8*)(Kb + (bi) * 16384 + kst1) = sk1; *(LAS bf16x8*)(Vb + (bi) * 16384 + vst0) = sv0; *(LAS bf16x8*)(Vb + (bi) * 16384 + vst1) = sv1; } while (0)
    ATT_LOAD(j_lo); ATT_WRITE(0);
    __syncthreads();
    for (int j = j_lo; j <= j_hi; ++j) {
        const int cur = (j - j_lo) & 1;
        if (j < j_hi) ATT_LOAD(j + 1);
        LAS const unsigned char* Kc = Kb + cur * 16384; LAS const unsigned char* Vc = Vb + cur * 16384;
        f32x16 s0, s1;
#pragma unroll
        for (int r = 0; r < 16; ++r) { s0[r] = 0.f; s1[r] = 0.f; }
#pragma unroll
        for (int d0 = 0; d0 < 8; ++d0) { const bf16x8 a0 = *(const LAS bf16x8*)(Kc + KSWZ(r32, (d0 * 16 + h * 8) * 2)); s0 = MFMA32(a0, qr[d0], s0); }
#pragma unroll
        for (int d0 = 0; d0 < 8; ++d0) { const bf16x8 a1 = *(const LAS bf16x8*)(Kc + KSWZ(32 + r32, (d0 * 16 + h * 8) * 2)); s1 = MFMA32(a1, qr[d0], s1); }
        if (j == 0 || j == 4) { const int kbase = p0 - 128 + 64 * j - qpos;
#pragma unroll
            for (int r = 0; r < 16; ++r) { const int d0 = kbase + crow(r, h), d1 = d0 + 32; if (d0 < -WIN || d0 > WIN) s0[r] = -1e30f; if (d1 < -WIN || d1 > WIN) s1[r] = -1e30f; } }
        float pmax = s0[0];
#pragma unroll
        for (int r = 1; r < 16; ++r) pmax = fmaxf(pmax, s0[r]);
#pragma unroll
        for (int r = 0; r < 16; ++r) pmax = fmaxf(pmax, s1[r]);
        pmax = xmax32(pmax);
        pmax -= m_run;
        float dlt = 0.f;
        if (__any(pmax > 8.f)) { dlt = fmaxf(pmax, 0.f); const float alpha = __builtin_amdgcn_exp2f(-dlt); l_run *= alpha;
#pragma unroll
            for (int d0 = 0; d0 < 4; ++d0)
#pragma unroll
                for (int r = 0; r < 16; ++r) o[d0][r] *= alpha; }
        const float mn = m_run + dlt; m_run = mn;
        float ps = 0.f;
#pragma unroll
        for (int r = 0; r < 16; ++r) { s0[r] = __builtin_amdgcn_exp2f(s0[r] - mn); s1[r] = __builtin_amdgcn_exp2f(s1[r] - mn); ps += s0[r] + s1[r]; }
        ps = xsum32(ps); l_run += ps;
        const bf16x8 pb0 = pack8(s0, 0), pb1 = pack8(s0, 1), pb2 = pack8(s1, 0), pb3 = pack8(s1, 1);
#pragma unroll
        for (int d0 = 0; d0 < 4; ++d0) {
#define ATT_VF(ks) ({ const s16x4 lo_ = vtr(Vc + vb0 + 4096 * (ks) + 512 * d0), hi_ = vtr(Vc + vb1 + 4096 * (ks) + 512 * d0); (bf16x8){lo_[0], lo_[1], lo_[2], lo_[3], hi_[0], hi_[1], hi_[2], hi_[3]}; })
            const bf16x8 v0 = ATT_VF(0), v1 = ATT_VF(1), v2 = ATT_VF(2), v3 = ATT_VF(3);
            o[d0] = MFMA32(v0, pb0, o[d0]); o[d0] = MFMA32(v1, pb1, o[d0]); o[d0] = MFMA32(v2, pb2, o[d0]); o[d0] = MFMA32(v3, pb3, o[d0]);
            __builtin_amdgcn_sched_group_barrier(0x100, 2, 0); __builtin_amdgcn_sched_group_barrier(0x8, 1, 0); __builtin_amdgcn_sched_group_barrier(0x100, 2, 0); __builtin_amdgcn_sched_group_barrier(0x8, 1, 0);
            __builtin_amdgcn_sched_group_barrier(0x100, 2, 0); __builtin_amdgcn_sched_group_barrier(0x8, 1, 0); __builtin_amdgcn_sched_group_barrier(0x100, 2, 0); __builtin_amdgcn_sched_group_barrier(0x8, 1, 0);
        }
        if (j < j_hi) ATT_WRITE(cur ^ 1);
        __syncthreads();
    }
    const float inv = 1.f / l_run; float ss = 0.f; bf16* yp = P.Y + trow * D + hq * HD + 4 * h;
    LAS unsigned char* YT = F.lds + 65536; const int ytl = (32 * (w & 1) + r32) * 520 + (w >> 1) * 128 + 4 * h;
#pragma unroll
    for (int d0 = 0; d0 < 4; ++d0)
#pragma unroll
        for (int g4 = 0; g4 < 4; ++g4) { const float a = o[d0][4 * g4] * inv, b2 = o[d0][4 * g4 + 1] * inv, c = o[d0][4 * g4 + 2] * inv, d = o[d0][4 * g4 + 3] * inv; ss += (a * a + b2 * b2) + (c * c + d * d);
            if constexpr (OUT_F8) { *(LAS unsigned*)(YT + ytl + 32 * d0 + 8 * g4) = pack4_fp8(a * YA_SCALE, b2 * YA_SCALE, c * YA_SCALE, d * YA_SCALE); } else { u32x2 wv; wv.x = cvt_pk_bf16(a, b2); wv.y = cvt_pk_bf16(c, d); *(u32x2*)(yp + 32 * d0 + 8 * g4) = wv; } }
    ss = xsum32(ss); if (h == 0) P.ssp[trow * SSPW + hq] = ss;
    if constexpr (OUT_F8) {
        __syncthreads();
#pragma unroll
        for (int i = 0; i < 4; ++i) { const int idx = tid + NWAVES * 64 * i, r = idx >> 5, c16 = idx & 31; const u32x2 lo = *(LAS const u32x2*)(YT + r * 520 + 16 * c16), hi = *(LAS const u32x2*)(YT + r * 520 + 16 * c16 + 8);
            *(u32x4*)((unsigned char*)P.Y + ((size_t)b * S + p0 + r) * D + kvh * 512 + 16 * c16) = (u32x4){lo.x, lo.y, hi.x, hi.y}; }
    }
#undef ATT_LOAD
#undef ATT_WRITE
}
DI void gmlp_phase(Frame& F, const Ptrs& P) {
    constexpr int NGM = NB * (S / CH) * GH;
    const int tid = F.tid, lane = F.lane, w = F.wave, r32 = lane & 31, h = lane >> 5, ch = tid & 15;
    LAS unsigned char* VC = F.lds;
    const int q4 = (lane & 15) >> 2, p4 = lane & 3, g16 = (lane >> 4) & 1;
    const int vb0 = 64 * (4 * h + q4) + 16 * ((2 * g16 + (p4 >> 1)) ^ h) + 8 * (p4 & 1), vb1 = 2048 + 64 * (4 * h + q4) + 16 * ((2 * g16 + (p4 >> 1)) ^ (h + 2)) + 8 * (p4 & 1);
    const int p = 32 * (w & 3) + r32, dp = w >> 2;
    int u = blockIdx.x; if (u >= NGM) return;
    bf16x8 raw[4], rawu[4];
#define GM_REMAP(uu) ((F.G == 256) ? ((((((uu) & 255) >> 3) + ((uu) & 7)) & 7) + 8 * (((((uu) & 7) * 4 + (((uu) & 255) >> 6)) << 2) + ((uu) >> 8))) : (uu))
#define GM_DECODE(uu_, hh_, t0_) const int ue_##hh_ = GM_REMAP(uu_); const int hh_ = ue_##hh_ % GH; const size_t t0_ = (size_t)(ue_##hh_ / (GH * (S / CH))) * S + (size_t)((ue_##hh_ / GH) % (S / CH)) * CH
#define GM_LOADV(hh_, t0_) do { _Pragma("unroll") for (int i = 0; i < 4; ++i) { const bf16* zr_ = P.Z + ((t0_) + (tid >> 4) + 32 * i) * INW + (hh_) * HD + 8 * ch; raw[i] = *(const bf16x8*)(zr_ + OVG); rawu[i] = *(const bf16x8*)(zr_ + OU); } } while (0)
    { GM_DECODE(u, hh0, t00); GM_LOADV(hh0, t00); }
    LAS unsigned char* WL = F.lds + 32768; const bool wlds = (F.G % GH) == 0; constexpr int WP = 264;
    LAS unsigned char* UL = F.lds + 69632;
    LAS unsigned char* YL = F.lds + 103424;
    if (wlds) { const bf16* wsrc = P.wsb + (size_t)(GM_REMAP(u) % GH) * CH * CH;
#pragma unroll
        for (int i = 0; i < 4; ++i) { const int idx = tid + NWAVES * 64 * i, row = idx >> 4, c16 = idx & 15; const u32x4 t = *(const u32x4*)(wsrc + (size_t)row * CH + 8 * c16);
            *(LAS u32x2*)(WL + row * WP + 16 * c16) = (u32x2){t.x, t.y}; *(LAS u32x2*)(WL + row * WP + 16 * c16 + 8) = (u32x2){t.z, t.w}; } }
    for (;;) {
        GM_DECODE(u, hh, t0);
        const size_t trow = t0 + p;
#pragma unroll
        for (int i = 0; i < 4; ++i) { const int r = (tid >> 4) + 32 * i; const u32x4 t = __builtin_bit_cast(u32x4, rawu[i]); *(LAS u32x2*)(UL + r * 264 + 16 * ch) = (u32x2){t.x, t.y}; *(LAS u32x2*)(UL + r * 264 + 16 * ch + 8) = (u32x2){t.z, t.w}; }
        const float bias = P.bsp[hh * CH + p];
        const f32x4 g0 = *(const f32x4*)(P.gn + hh * HD + 8 * ch), g1 = *(const f32x4*)(P.gn + hh * HD + 8 * ch + 4);
#pragma unroll
        for (int i = 0; i < 4; ++i) { const int r = (tid >> 4) + 32 * i;
            float v[8]; float s1 = 0.f;
#pragma unroll
            for (int k = 0; k < 8; ++k) { v[k] = bf2f((bf16)raw[i][k]); s1 += v[k]; }
            s1 = sum16(s1);
            const float mu = s1 * (1.f / 128); float s2 = 0.f;
#pragma unroll
            for (int k = 0; k < 8; ++k) { v[k] -= mu; s2 += v[k] * v[k]; }
            s2 = sum16(s2);
            const float rs = rsqrtf(s2 * (1.f / 128) + EPS);
            u32x4 pk; pk.x = cvt_pk_bf16(v[0] * rs * g0.x, v[1] * rs * g0.y); pk.y = cvt_pk_bf16(v[2] * rs * g0.z, v[3] * rs * g0.w); pk.z = cvt_pk_bf16(v[4] * rs * g1.x, v[5] * rs * g1.y); pk.w = cvt_pk_bf16(v[6] * rs * g1.z, v[7] * rs * g1.w);
            *(LAS u32x4*)(VC + vimg_off(r, ch)) = pk; }
        __syncthreads();
        const int un = u + F.G; const bool has = un < NGM;
        if (has) { GM_DECODE(un, hhn, t0n); GM_LOADV(hhn, t0n); }
        const bf16* wrow = P.wsb + ((size_t)hh * CH + p) * CH + 4 * h;
        f32x16 acc[2];
#pragma unroll
        for (int dd = 0; dd < 2; ++dd)
#pragma unroll
            for (int r = 0; r < 16; ++r) acc[dd][r] = 0.f;
#pragma unroll
        for (int ks = 0; ks < 8; ++ks) { LAS const unsigned char* wlp = WL + p * WP + 2 * (4 * h + 16 * ks);
            const s16x4 wl = wlds ? *(LAS const s16x4*)wlp : *(const s16x4*)(wrow + 16 * ks), wh = wlds ? *(LAS const s16x4*)(wlp + 16) : *(const s16x4*)(wrow + 16 * ks + 8);
            const bf16x8 bfrag = (bf16x8){wl[0], wl[1], wl[2], wl[3], wh[0], wh[1], wh[2], wh[3]};
#pragma unroll
            for (int dd = 0; dd < 2; ++dd) { const int d0 = 2 * dp + dd; const s16x4 lo = vtr(VC + vb0 + 4096 * ks + 512 * d0), hi = vtr(VC + vb1 + 4096 * ks + 512 * d0);
                acc[dd] = MFMA32(((bf16x8){lo[0], lo[1], lo[2], lo[3], hi[0], hi[1], hi[2], hi[3]}), bfrag, acc[dd]); } }
        float ss = 0.f; bf16* yp = P.Y + trow * D + AW + hh * HD + 4 * h;
#pragma unroll
        for (int dd = 0; dd < 2; ++dd)
#pragma unroll
            for (int g4 = 0; g4 < 4; ++g4) { const int dof = 32 * (2 * dp + dd) + 8 * g4; const s16x4 u4 = *(LAS const s16x4*)(UL + p * 264 + 2 * (dof + 4 * h));
                const float a = bf2f((bf16)u4[0]) * (acc[dd][4 * g4] + bias), b2 = bf2f((bf16)u4[1]) * (acc[dd][4 * g4 + 1] + bias), c2 = bf2f((bf16)u4[2]) * (acc[dd][4 * g4 + 2] + bias), d2 = bf2f((bf16)u4[3]) * (acc[dd][4 * g4 + 3] + bias);
                ss += (a * a + b2 * b2) + (c2 * c2 + d2 * d2); if constexpr (OUT_F8) { *(LAS unsigned*)(YL + p * 136 + 4 * h + dof) = pack4_fp8(a * YA_SCALE, b2 * YA_SCALE, c2 * YA_SCALE, d2 * YA_SCALE); } else { u32x2 wv; wv.x = cvt_pk_bf16(a, b2); wv.y = cvt_pk_bf16(c2, d2); *(u32x2*)(yp + dof) = wv; } }
        ss = xsum32(ss); if (h == 0) P.ssp[trow * SSPW + 8 + hh * 2 + dp] = ss;
        __syncthreads();
        if constexpr (OUT_F8) {
#pragma unroll
            for (int i = 0; i < 2; ++i) { const int idx = tid + NWAVES * 64 * i, r = idx >> 3, c16 = idx & 7; const u32x2 lo = *(LAS const u32x2*)(YL + r * 136 + 16 * c16), hi = *(LAS const u32x2*)(YL + r * 136 + 16 * c16 + 8);
                *(u32x4*)((unsigned char*)P.Y + (t0 + r) * D + AW + hh * HD + 16 * c16) = (u32x4){lo.x, lo.y, hi.x, hi.y}; } }
        if (!has) break;
        u = un;
    }
#undef GM_DECODE
#undef GM_REMAP
#undef GM_LOADV
}
DI void p3_mixer(Frame& F, const Ptrs& P) {
    constexpr int NATT = NB * KVH * (S / 64);
    for (int u = blockIdx.x; u < NATT; u += F.G) { const int pb = u % (S / 64), kvh = (u / (S / 64)) % KVH, b = u / ((S / 64) * KVH); attn_unit(F, P, b, kvh, pb); }
    __syncthreads();
    gmlp_phase(F, P);
}
DI void bf4_to_f(const u32x2 a, f32x4& v) { v.x = __uint_as_float(a.x << 16); v.y = __uint_as_float(a.x & 0xffff0000u); v.z = __uint_as_float(a.y << 16); v.w = __uint_as_float(a.y & 0xffff0000u); }
DI void p5_thin(Frame& F, const Ptrs& P) {
    LAS float* A1 = (LAS float*)F.lds; LAS float* A2 = A1 + D; LAS float* A3 = A2 + D; LAS float* WG = A3 + D;
    LAS unsigned* lcnt = (LAS unsigned*)(WG + NG * D); LAS unsigned* lbase = lcnt + NE; LAS unsigned* lent = lbase + NE; LAS float* lwt = (LAS float*)(lent + NE * 128);
    constexpr int RPB = 64; const int lane = F.lane;
    bool wgdone = false;
    for (int blk = blockIdx.x; blk < T / RPB; blk += F.G) {
        const int row_base = blk * RPB, b = row_base / S;
        u32x2 cm[8]; f32x4 cx[8];
        { const GAS u32x2* mr = (const GAS u32x2*)(P.MIX + (size_t)(row_base + F.wave) * D) + lane; const GAS f32x4* xr = (const GAS f32x4*)(P.x + (size_t)(row_base + F.wave) * D) + lane;
#pragma unroll
          for (int j = 0; j < 8; ++j) { cm[j] = __builtin_nontemporal_load(mr + 64 * j); cx[j] = __builtin_nontemporal_load(xr + 64 * j); } }
        __syncthreads();
        if (!wgdone) { for (int i = F.tid; i < NG * D / 4; i += NWAVES * 64) *(LAS f32x4*)(WG + 4 * i) = *(const f32x4*)(P.wrgT + 4 * i); wgdone = true; }
        for (int i = F.tid; i < D; i += NWAVES * 64) { A1[i] = modv(P, b, 2 * D + i) * P.g_mix_post[i]; A2[i] = P.g_ffn_pre[i] * (1.f + modv(P, b, 4 * D + i)); A3[i] = modv(P, b, 3 * D + i); }
        if (F.tid < NE) lcnt[F.tid] = 0u;
        __syncthreads();
        for (int rr = F.wave; rr < RPB; rr += NWAVES) {
            const int row = row_base + rr; u32x2 nm[8]; f32x4 nx[8];
            if (rr + NWAVES < RPB) { const GAS u32x2* mr = (const GAS u32x2*)(P.MIX + (size_t)(row + NWAVES) * D) + lane; const GAS f32x4* xr = (const GAS f32x4*)(P.x + (size_t)(row + NWAVES) * D) + lane;
#pragma unroll
                for (int j = 0; j < 8; ++j) { nm[j] = __builtin_nontemporal_load(mr + 64 * j); nx[j] = __builtin_nontemporal_load(xr + 64 * j); } }
            f32x4 v[8]; float ss = 0.f;
#pragma unroll
            for (int j = 0; j < 8; ++j) { bf4_to_f(cm[j], v[j]); ss += (v[j].x * v[j].x + v[j].y * v[j].y) + (v[j].z * v[j].z + v[j].w * v[j].w); }
            float r = rsqrtf(wave_sum(ss) * (1.f / D) + EPS); ss = 0.f;
            GAS u32x2* ho = (GAS u32x2*)(P.HB + (size_t)row * D) + lane;
#pragma unroll
            for (int j = 0; j < 8; ++j) { const f32x4 a1 = *(const LAS f32x4*)(A1 + 4 * lane + 256 * j); v[j] = cx[j] + a1 * (v[j] * r); u32x2 hw; hw.x = cvt_pk_bf16(v[j].x, v[j].y); hw.y = cvt_pk_bf16(v[j].z, v[j].w); __builtin_nontemporal_store(hw, ho + 64 * j); ss += (v[j].x * v[j].x + v[j].y * v[j].y) + (v[j].z * v[j].z + v[j].w * v[j].w); }
            r = rsqrtf(wave_sum(ss) * (1.f / D) + EPS);
            float gl[4]; f32x2 g2[4] = {{0.f, 0.f}, {0.f, 0.f}, {0.f, 0.f}, {0.f, 0.f}}; GAS u32x2* fo = (GAS u32x2*)(P.A + (size_t)row * D) + lane;
#pragma unroll
            for (int j = 0; j < 8; ++j) { const int col = 4 * lane + 256 * j; const f32x4 a2 = *(const LAS f32x4*)(A2 + col), a3 = *(const LAS f32x4*)(A3 + col); v[j] = v[j] * r * a2 + a3;
                if constexpr (MOE_FP8) { ((GAS unsigned*)((unsigned char*)P.A + (size_t)row * D) + lane)[64 * j] = pack4_fp8(v[j].x, v[j].y, v[j].z, v[j].w); } else { u32x2 wv; wv.x = cvt_pk_bf16(v[j].x, v[j].y); wv.y = cvt_pk_bf16(v[j].z, v[j].w); fo[64 * j] = wv; }
#pragma unroll
                for (int g = 0; g < 4; ++g) { const f32x4 wg = *(const LAS f32x4*)(WG + g * D + col); g2[g] += (f32x2){v[j].x, v[j].y} * (f32x2){wg.x, wg.y}; g2[g] += (f32x2){v[j].z, v[j].w} * (f32x2){wg.z, wg.w}; } }
            int gi = 0; float gmax = -1e30f;
#pragma unroll
            for (int g = 0; g < 4; ++g) { gl[g] = wave_sum(g2[g].x + g2[g].y) + P.b_rg[g]; if (gl[g] > gmax) { gmax = gl[g]; gi = g; } }
            float gsum = 0.f;
#pragma unroll
            for (int g = 0; g < 4; ++g) gsum += expf(gl[g] - gmax);
            const float gval = 1.f / gsum;
            float el[4]; f32x2 ea2[4] = {{0.f, 0.f}, {0.f, 0.f}, {0.f, 0.f}, {0.f, 0.f}};
#pragma unroll
            for (int e = 0; e < 4; ++e) { const float* we = P.wreT + (size_t)(gi * EPG + e) * D;
#pragma unroll
                for (int j = 0; j < 8; ++j) { const f32x4 wv = *(const f32x4*)(we + 4 * lane + 256 * j); ea2[e] += (f32x2){v[j].x, v[j].y} * (f32x2){wv.x, wv.y}; ea2[e] += (f32x2){v[j].z, v[j].w} * (f32x2){wv.z, wv.w}; } }
            int e1 = 0; float m1 = -1e30f;
#pragma unroll
            for (int e = 0; e < 4; ++e) { el[e] = wave_sum(ea2[e].x + ea2[e].y) + P.b_re[gi * EPG + e]; if (el[e] > m1) { m1 = el[e]; e1 = e; } }
            int e2 = 0; float m2 = -1e30f;
#pragma unroll
            for (int e = 0; e < 4; ++e) if (e != e1 && el[e] > m2) { m2 = el[e]; e2 = e; }
            const float p2 = expf(m2 - m1); const float w1 = gval / (1.f + p2), w2 = gval * p2 / (1.f + p2);
            if (lane == 0) {
                const int ea = gi * EPG + e1, eb = gi * EPG + e2;
                const unsigned pa = __hip_atomic_fetch_add(&lcnt[ea], 1u, __ATOMIC_RELAXED, __HIP_MEMORY_SCOPE_WORKGROUP); lent[ea * 128 + pa] = (unsigned)row * 2u; lwt[ea * 128 + pa] = w1;
                const unsigned pb = __hip_atomic_fetch_add(&lcnt[eb], 1u, __ATOMIC_RELAXED, __HIP_MEMORY_SCOPE_WORKGROUP); lent[eb * 128 + pb] = (unsigned)row * 2u + 1u; lwt[eb * 128 + pb] = w2;
            }
#pragma unroll
            for (int j = 0; j < 8; ++j) { cm[j] = nm[j]; cx[j] = nx[j]; }
        }
        __syncthreads();
        if (F.tid < NE) lbase[F.tid] = atomicAdd((unsigned*)P.ctlcnt + F.tid, lcnt[F.tid]);
        __syncthreads();
        for (int i = F.tid; i < NE * 128; i += NWAVES * 64) { const int e = i >> 7, k = i & 127; if ((unsigned)k < lcnt[e]) { const unsigned dst = lbase[e] + k; P.list[e * T + dst] = lent[i]; P.lw[e * T + dst] = lwt[i]; } }
    }
    __syncthreads();
}
DI void fp8x4_to_f(unsigned a, f32x4& v) { const f32x2 lo = __builtin_amdgcn_cvt_pk_f32_fp8((int)a, false), hi = __builtin_amdgcn_cvt_pk_f32_fp8((int)a, true); v.x = lo.x; v.y = lo.y; v.z = hi.x; v.w = hi.y; }
DI void p8_final(Frame& F, const Ptrs& P) {
    LAS float* A4 = (LAS float*)F.lds; constexpr int RPB = 64; const int lane = F.lane;
    typedef unsigned YT __attribute__((ext_vector_type(YK_FP8 ? 1 : 2)));
    constexpr int YROW = YK_FP8 ? D : 2 * D;
    for (int blk = blockIdx.x; blk < T / RPB; blk += F.G) {
        const int row_base = blk * RPB, b = row_base / S;
        YT c0[8], c1[8]; u32x2 ch[8];
#define P8_LOAD(Y0_, Y1_, H_, ROW_) do { const GAS YT* y0_ = (const GAS YT*)((const unsigned char*)P.YK + (size_t)(2 * (ROW_)) * YROW) + lane; const GAS YT* y1_ = (const GAS YT*)((const unsigned char*)P.YK + (size_t)(2 * (ROW_) + 1) * YROW) + lane; \
            const GAS u32x2* hr_ = (const GAS u32x2*)(P.HB + (size_t)(ROW_) * D) + lane; \
            _Pragma("unroll") for (int j = 0; j < 8; ++j) { Y0_[j] = __builtin_nontemporal_load(y0_ + 64 * j); Y1_[j] = __builtin_nontemporal_load(y1_ + 64 * j); H_[j] = __builtin_nontemporal_load(hr_ + 64 * j); } } while (0)
        P8_LOAD(c0, c1, ch, row_base + F.wave);
        __syncthreads();
        for (int i = F.tid; i < D; i += NWAVES * 64) A4[i] = modv(P, b, 5 * D + i) * P.g_ffn_post[i];
        __syncthreads();
        for (int rr = F.wave; rr < RPB; rr += NWAVES) {
            const int row = row_base + rr; YT n0[8], n1[8]; u32x2 nh[8];
            if (rr + NWAVES < RPB) P8_LOAD(n0, n1, nh, row + NWAVES);
            f32x4 v[8]; float ss = 0.f;
#pragma unroll
            for (int j = 0; j < 8; ++j) { f32x4 a, c;
                if constexpr (YK_FP8) { fp8x4_to_f(c0[j][0], a); fp8x4_to_f(c1[j][0], c); v[j] = (a + c) * (1.f / Y8_SCALE); }
                else { u32x2 t0, t1; t0.x = c0[j][0]; t0.y = c0[j][YK_FP8 ? 0 : 1]; t1.x = c1[j][0]; t1.y = c1[j][YK_FP8 ? 0 : 1]; bf4_to_f(t0, a); bf4_to_f(t1, c); v[j] = a + c; }
                ss += (v[j].x * v[j].x + v[j].y * v[j].y) + (v[j].z * v[j].z + v[j].w * v[j].w); }
            const float r = rsqrtf(wave_sum(ss) * (1.f / D) + EPS);
            GAS f32x4* ho = (GAS f32x4*)(P.out + (size_t)row * D) + lane;
#pragma unroll
            for (int j = 0; j < 8; ++j) { const f32x4 a4 = *(const LAS f32x4*)(A4 + 4 * lane + 256 * j); { f32x4 hv; bf4_to_f(ch[j], hv); __builtin_nontemporal_store(hv + a4 * (v[j] * r), ho + 64 * j); } }
#pragma unroll
            for (int j = 0; j < 8; ++j) { c0[j] = n0[j]; c1[j] = n1[j]; ch[j] = nh[j]; }
        }
#undef P8_LOAD
    }
}

struct Args { const void* in[23]; float* out; unsigned char* ws; int ph_lo, ph_hi; };
__global__ void __launch_bounds__(NWAVES * 64, 2) mega_fwd(Args args) {
    extern __shared__ __attribute__((aligned(16))) unsigned char lds[];
    Frame F;
    F.lds = (LAS unsigned char*)lds; F.MISC = (volatile LAS unsigned*)(F.lds + MISC_OFF);
    F.tid = threadIdx.x; F.lane = F.tid & 63; F.wave = __builtin_amdgcn_readfirstlane(F.tid >> 6); F.G = gridDim.x; F.gw = blockIdx.x * NWAVES + F.wave; F.NGW = F.G * NWAVES;
    unsigned char* ws = args.ws; F.ctl = (gu32*)(ws + WS_CTL);
#define PTRS(P) Ptrs P; { P.x = (const float*)args.in[0]; P.c = (const float*)args.in[1]; P.pos = (const int*)args.in[2]; P.w_ada = (const float*)args.in[3]; P.b_ada = (const float*)args.in[4]; P.g_mix_pre = (const float*)args.in[5]; \
    P.g_mix_post = (const float*)args.in[6]; P.w_in = (const float*)args.in[7]; P.sink = (const float*)args.in[8]; P.gn = (const float*)args.in[9]; P.wsp = (const float*)args.in[10]; P.bsp = (const float*)args.in[11]; \
    P.gg = (const float*)args.in[12]; P.w_out = (const float*)args.in[13]; P.g_ffn_pre = (const float*)args.in[14]; P.g_ffn_post = (const float*)args.in[15]; P.w_rg = (const float*)args.in[16]; P.b_rg = (const float*)args.in[17]; \
    P.w_re = (const float*)args.in[18]; P.b_re = (const float*)args.in[19]; P.w_gate = (const float*)args.in[20]; P.w_up = (const float*)args.in[21]; P.w_down = (const float*)args.in[22]; P.out = args.out; \
    P.mod = (float*)(ws + WS_MOD); P.rope = (float*)(ws + WS_ROPE); P.ssp = (float*)(ws + WS_SSP); P.list = (unsigned*)(ws + WS_LIST); P.lw = (float*)(ws + WS_LW); P.wrgT = (float*)(ws + WS_WRG); P.wreT = (float*)(ws + WS_WRE); \
    P.wsb = (bf16*)(ws + WS_WSB); P.WinT = (bf16*)(ws + WS_WIN); P.WoT = (bf16*)(ws + WS_WO); P.WguT = (bf16*)(ws + WS_WGU); P.WdT = (bf16*)(ws + WS_WD); P.A = (bf16*)(ws + WS_A); P.Z = (bf16*)(ws + WS_Z); P.Y = (bf16*)(ws + WS_Y); \
    P.MIX = (bf16*)(ws + WS_MIX); P.HB = (bf16*)(ws + WS_HB); P.ctlcnt = (unsigned*)(ws + WS_CTL) + CW_CNT; P.wmaxw = (unsigned*)(ws + WS_CTL) + CW_WMAX; P.asc = (float*)(ws + WS_ASC); P.HID = (bf16*)(ws + WS_HID); P.YK = (bf16*)(ws + WS_YK); }
    for (int u = F.tid; u < (LDS_BYTES - MISC_OFF) / 4; u += NWAVES * 64) ((LAS unsigned*)(F.lds + MISC_OFF))[u] = 0u;
    __syncthreads();
    const int lo = args.ph_lo, hi = args.ph_hi;
    XcdBarrier bar; bar.bar = (unsigned*)(F.ctl + CW_BAR); bar.x = 0; bar.st = nullptr;
    if (hi - lo > 1) bar = xcd_barrier_post((unsigned*)(F.ctl + CW_BAR), F.MISC + 24);
#define IN(k) (lo <= (k) && (k) < hi)
#define SEAM(k) do { if (IN(k) && IN((k) + 1)) xcd_barrier(bar); } while (0)
    LAS unsigned* tab = (LAS unsigned*)(F.lds + TAB_OFF); LAS int* tp = (LAS int*)(F.lds + MISC_OFF);

    if (IN(0)) { PTRS(P); p0_prologue(F, P); } SEAM(0);
    if (IN(1)) { PTRS(P); p1_norm(F, P); } SEAM(1);
    if (IN(2)) { PTRS(P); const int ncv = conv_wgs(F.G), gg2 = F.G - ncv;
        if ((int)blockIdx.x < gg2) { pg8::DenseOrder S2; S2.init(P.A, P.WinT, T, INW, INP_I8 ? D / 2 : D, gg2, (int)blockIdx.x);
            LAS f32x2* rt2 = (LAS f32x2*)tab; const float wq = INP_I8 ? __uint_as_float(__hip_atomic_load(P.wmaxw, RLX_AGENT)) * (1.f / 127.f) : 1.f;
            for (int idx = F.tid; idx < 4 * 256; idx += NWAVES * 64) { pg8::Unit u; if (S2.next(idx >> 8, u)) { const int row = u.pm * 256 + (idx & 255); rt2[idx] = (f32x2){INP_I8 ? P.asc[row] * wq : 1.f, (float)P.pos[row]}; } }
            __syncthreads();
            pg8::EpiInproj E{P.Z, rt2};
            pg8::gemm_core<pg8::EpiInproj, pg8::DenseOrder, false, false, INP_I8 ? 2 : 0>(F.lds, S2, E, nullptr); }
        else { LAS float* scr = (LAS float*)(F.lds + F.wave * 16384); const int per = CONV_ITEMS / (ncv * NWAVES), f0 = P0_SPLIT + (((int)blockIdx.x - gg2) * NWAVES + F.wave) * per; convert_range(P, f0, f0 + per, 1, scr, F.lane); } } SEAM(2);
    if (IN(3)) { PTRS(P); p3_mixer(F, P); } SEAM(3);
    if (IN(4)) { PTRS(P); pg8::DenseOrder S4; S4.init(P.Y, P.WoT, T, D, OUT_F8 ? D / 2 : D, F.G, (int)blockIdx.x);
        LAS f32x2* rr = (LAS f32x2*)tab; LAS unsigned* gt4 = tab + 4 * 512; pg8::Unit u; S4.gather = OUT_F8 != 0;
        for (int i = 0; i < 4 && S4.next(i, u); ++i) { f32x4 v[4];
#pragma unroll
            for (int j = 0; j < 4; ++j) { const int idx = F.tid + NWAVES * 64 * j; v[j] = ((idx & 7) < 6) ? *(const f32x4*)(P.ssp + (size_t)(u.pm * 256 + (idx >> 3)) * SSPW + 4 * (idx & 7)) : (f32x4){0.f, 0.f, 0.f, 0.f}; }
#pragma unroll
            for (int j = 0; j < 4; ++j) { const int idx = F.tid + NWAVES * 64 * j, r = idx >> 3, q = idx & 7; const float s = (v[j].x + v[j].y) + (v[j].z + v[j].w); float sa = q < 2 ? s : 0.f, sg = q < 2 ? 0.f : s;
                sa += __shfl_xor(sa, 1); sg += __shfl_xor(sg, 1); sg += __shfl_xor(sg, 2); sg += __shfl_xor(sg, 4);
                if (q == 0) { const float ra = rsqrtf(sa * (1.f / AW) + EPS), rg = rsqrtf(sg * (1.f / AW) + EPS); rr[i * 256 + r] = (f32x2){ra / rg, rg}; gt4[i * 256 + r] = (unsigned)(u.pm * 256 + r) * (unsigned)D; } } }
        __syncthreads();
        pg8::EpiOutproj E{P.MIX, rr};
        if constexpr (OUT_F8) pg8::gemm_core<pg8::EpiOutproj, pg8::DenseOrder, true, true, 1>(F.lds, S4, E, gt4);
        else pg8::gemm_core<pg8::EpiOutproj, pg8::DenseOrder, false, true, 0>(F.lds, S4, E, nullptr); } SEAM(4);
    if (IN(5)) { PTRS(P); p5_thin(F, P); } SEAM(5);
    if (IN(6) || IN(7)) {
        if (F.tid == 0) { int o = 0; for (int e = 0; e < NE; ++e) { tp[e] = o; o += (int)((__hip_atomic_load(F.ctl + CW_CNT + e, RLX_AGENT) + 255u) >> 8); } tp[NE] = o; }
        __syncthreads();
    }
    if (IN(6)) { PTRS(P); pg8::MoeOrder S6{(const char*)P.A, (const char*)P.WguT, MOE_FP8 ? D / 2 : D, FF / 128, (size_t)2048 * 2048 * (MOE_FP8 ? 1 : 2), tp, F.G, (int)blockIdx.x, true};
        { const int W = F.G >> 3; bool ok = (F.G % 8) == 0;
#pragma unroll
          for (int x = 0; x < 8; ++x) ok = ok && ((S6.group_units(x) + W - 1) / W <= MAX_SLOTS);
          S6.xg = ok; }
        LAS unsigned* gt = tab; LAS float* wt = (LAS float*)(tab + MAX_SLOTS * 256); pg8::Unit u;
#pragma unroll
        for (int j = 0; j < 4; ++j) { const int idx = F.tid + NWAVES * 64 * j, i = idx >> 8, r = idx & 255;
            if (i < MAX_SLOTS && S6.next(i, u)) { const unsigned n = __hip_atomic_load(F.ctl + CW_CNT + u.e, RLX_AGENT); const unsigned m = (unsigned)u.pm * 256u + r;
                const bool ok = m < n; gt[i * 256 + r] = ok ? (P.list[u.e * T + m] >> 1) * (unsigned)(MOE_FP8 ? D : D * 2) : 0u; wt[i * 256 + r] = ok ? P.lw[u.e * T + m] : 0.f; } }
        __syncthreads();
        pg8::EpiGateUp E{(unsigned char*)P.HID, wt, tp}; pg8::gemm_core<pg8::EpiGateUp, pg8::MoeOrder, true, false, MOE_FP8 ? 1 : 0>(F.lds, S6, E, gt);
        if (conv_wgs(F.G)) {
            LAS float* scr = (LAS float*)(F.lds + F.wave * 16384); const int nmax = S6.max_units();
            int nidle = 0, myidx = -1;
            if (S6.xcd()) { const int W = F.G >> 3, mx = (int)blockIdx.x & 7, mr = (int)blockIdx.x >> 3;
                for (int x = 0; x < 8; ++x) { const int U = S6.group_units(x), q = (U + W - 1) / W; const int first = (q < nmax) ? 0 : U - (nmax - 1) * W;
                    if (x == mx && mr >= first) myidx = nidle + (mr - first); nidle += W - first; } }
            else { const int rem = (tp[NE] * (FF / 128)) % F.G; if (rem != 0) { nidle = F.G - rem; if ((int)blockIdx.x >= rem) myidx = (int)blockIdx.x - rem; } }
            if (nidle < 96) convert_range(P, I_DOWN0 + F.gw, NITEMS, F.NGW, scr, F.lane);
            else if (myidx >= 0) convert_range(P, I_DOWN0 + myidx * NWAVES + F.wave, NITEMS, nidle * NWAVES, scr, F.lane);
        } } SEAM(6);
    if (IN(7)) { PTRS(P); pg8::MoeOrder S7{(const char*)P.HID, (const char*)P.WdT, MOE_FP8 ? FF / 2 : FF, D / 256, (size_t)2048 * 1024 * (MOE_FP8 ? 1 : 2), tp, F.G, (int)blockIdx.x, true, true};
        { const int W = F.G >> 3; bool ok = (F.G % 8) == 0;
#pragma unroll
          for (int x = 0; x < 8; ++x) ok = ok && ((S7.group_units(x) + W - 1) / W <= MAX_SLOTS);
          S7.xg = ok; }
        LAS unsigned* dt = tab; LAS unsigned* gt7 = tab + MAX_SLOTS * 256; pg8::Unit u;
#pragma unroll
        for (int j = 0; j < 4; ++j) { const int idx = F.tid + NWAVES * 64 * j, i = idx >> 8, r = idx & 255;
            if (i < MAX_SLOTS && S7.next(i, u)) { const unsigned n = __hip_atomic_load(F.ctl + CW_CNT + u.e, RLX_AGENT); const unsigned m = (unsigned)u.pm * 256u + r;
                dt[i * 256 + r] = m < n ? P.list[u.e * T + m] : 0xffffffffu; gt7[i * 256 + r] = (unsigned)((tp[u.e] + u.pm) * 256 + r) * (unsigned)(MOE_FP8 ? FF : FF * 2); } }
        __syncthreads();
        pg8::EpiDown E{(unsigned char*)P.YK, dt}; pg8::gemm_core<pg8::EpiDown, pg8::MoeOrder, true, false, MOE_FP8 ? 1 : 0>(F.lds, S7, E, gt7); } SEAM(7);
    if (IN(8)) { PTRS(P); p8_final(F, P);
        if (__hip_atomic_load(F.ctl + CW_BAR + XB_TMO, RLX_AGENT) != 0u) { const float q = __builtin_nanf(""); for (int row = F.gw; row < T; row += F.NGW) for (int j = F.lane; j < D; j += 64) P.out[(size_t)row * D + j] = q; } }
#undef IN
#undef SEAM
}

extern "C" void kernel_launch(void* const* d_in, const int* in_sizes, int n_in, void* d_out, int out_size, void* d_ws, size_t ws_size, hipStream_t stream) {
    static int grid = 0;
    if (grid == 0) {
        if (n_in != 23 || in_sizes[0] != T * D || out_size != T * D || ws_size < WS_END) { fprintf(stderr, "kernel_launch: unexpected shapes / workspace (%d inputs, ws %zu)\n", n_in, ws_size); grid = -1; return; }
        int dev = 0, cus = 0, per_cu = 0;
        if (hipGetDevice(&dev) != hipSuccess || hipDeviceGetAttribute(&cus, hipDeviceAttributeMultiprocessorCount, dev) != hipSuccess) { grid = -1; return; }
        if (hipFuncSetAttribute((const void*)mega_fwd, hipFuncAttributeMaxDynamicSharedMemorySize, LDS_BYTES) != hipSuccess) { grid = -1; return; }
        if (hipOccupancyMaxActiveBlocksPerMultiprocessor(&per_cu, (const void*)mega_fwd, NWAVES * 64, LDS_BYTES) != hipSuccess || per_cu < 1) fprintf(stderr, "kernel_launch: occupancy query says %d\n", per_cu);
        (void)hipGetLastError();
        grid = cus;
        if (grid != 256) fprintf(stderr, "kernel_launch: %d CUs (built for 256)\n", grid);
    }
    if (grid < 0) return;
    (void)hipMemsetAsync((char*)d_ws + WS_CTL, 0, CTL_ZERO_BYTES, stream);
    Args a; memset(&a, 0, sizeof(a));
    for (int i = 0; i < 23; ++i) a.in[i] = d_in[i];
    a.out = (float*)d_out; a.ws = (unsigned char*)d_ws; a.ph_lo = 0; a.ph_hi = 9;
    hipLaunchKernelGGL(mega_fwd, dim3(grid), dim3(NWAVES * 64), LDS_BYTES, stream, a);
}
```
